# Optimizing an MI355X kernel written in HIP

```python
import math
import jax, jax.numpy as jnp
from jax import lax
import numpy as np

D_MODEL = 1024
BATCH = 16
SEQ = 2048
DEPTH = 1

CHUNK = 64
Q_BLOCK = 128

MLA_HEADS = 8
QK_NOPE_DIM = 64
QK_ROPE_DIM = 32
V_HEAD_DIM = 64
Q_LORA_RANK = 256
KV_LORA_RANK = 128
ROPE_THETA = 10000.0
ATTN_WIDTH = MLA_HEADS * V_HEAD_DIM

CONV_GROUPS = 8
CONV_DIM = D_MODEL // 2
CONV_WIDTH = 3

MIX_WIDTH = ATTN_WIDTH + CONV_DIM
IN_SIZES = (Q_LORA_RANK, KV_LORA_RANK, QK_ROPE_DIM, CONV_DIM, CONV_DIM, CONV_DIM)
IN_COLS = sum(IN_SIZES)
IN_OFFSETS = tuple(int(v) for v in np.cumsum(IN_SIZES)[:-1])

N_GROUPS = 4
EXPERTS_PER_GROUP = 8
N_EXPERTS = N_GROUPS * EXPERTS_PER_GROUP
TOP_K = 2
D_EXPERT = 256
DISPATCH_BLOCK = 128

N_MOD = 6
RMS_EPS = 1e-6
NEG_INF = -1e30

kernel_name = 'hymba_mla_shortconv_hmoe_adaln_block'


def rms_norm(x, g):
    xf = x.astype(jnp.float32)
    y = xf * lax.rsqrt(jnp.mean(xf * xf, axis=-1, keepdims=True) + RMS_EPS)
    return (y * g.astype(jnp.float32)).astype(x.dtype)


def modulate(h, shift, scale):
    return h * (1.0 + scale[:, None, :]) + shift[:, None, :]


def rope_tables(positions):
    inv_freq = 1.0 / (ROPE_THETA ** (jnp.arange(0, QK_ROPE_DIM, 2, dtype=jnp.float32) / QK_ROPE_DIM))
    ang = positions.astype(jnp.float32)[..., None] * inv_freq
    return jnp.cos(ang), jnp.sin(ang)


def apply_rope(x, cos, sin):
    xf = x.astype(jnp.float32)
    x1, x2 = xf[..., : QK_ROPE_DIM // 2], xf[..., QK_ROPE_DIM // 2:]
    return jnp.concatenate([x1 * cos - x2 * sin, x2 * cos + x1 * sin], axis=-1).astype(x.dtype)


def mla_mixer(q_c, kv_c, k_r, positions, q_norm_g, kv_norm_g, w_uq, w_uk, w_uv):
    B, S, _ = q_c.shape
    H, DN, DR, DV = MLA_HEADS, QK_NOPE_DIM, QK_ROPE_DIM, V_HEAD_DIM
    q = (rms_norm(q_c, q_norm_g) @ w_uq).reshape(B, S, H, DN + DR)
    q_nope, q_rope = q[..., :DN], q[..., DN:]
    kv = rms_norm(kv_c, kv_norm_g)
    k_nope = (kv @ w_uk).reshape(B, S, H, DN)
    v = (kv @ w_uv).reshape(B, S, H, DV)
    cos, sin = rope_tables(positions)
    q_rope = apply_rope(q_rope, cos[:, :, None, :], sin[:, :, None, :])
    k_rope = apply_rope(k_r, cos, sin)
    nq = S // Q_BLOCK
    qn_b = q_nope.reshape(B, nq, Q_BLOCK, H, DN).transpose(1, 0, 2, 3, 4)
    qr_b = q_rope.reshape(B, nq, Q_BLOCK, H, DR).transpose(1, 0, 2, 3, 4)
    k_chunk = jnp.arange(S) // CHUNK
    sm_scale = 1.0 / math.sqrt(DN + DR)

    def attend_block(args):
        qn, qr, bi = args
        s = (jnp.einsum('bqhd,bkhd->bhqk', qn, k_nope)
             + jnp.einsum('bqhr,bkr->bhqk', qr, k_rope)).astype(jnp.float32) * sm_scale
        q_chunk = (bi * Q_BLOCK + jnp.arange(Q_BLOCK)) // CHUNK
        allowed = k_chunk[None, :] <= q_chunk[:, None]
        s = jnp.where(allowed[None, None], s, NEG_INF)
        p = jax.nn.softmax(s, axis=-1).astype(v.dtype)
        return jnp.einsum('bhqk,bkhd->bqhd', p, v)

    out = lax.map(attend_block, (qn_b, qr_b, jnp.arange(nq)))
    return out.transpose(1, 0, 2, 3, 4).reshape(B, S, ATTN_WIDTH)


def short_conv_mixer(u, b_gate, c_gate, conv_w, conv_b):
    z = c_gate * u
    rhs = conv_w.reshape(CONV_WIDTH, 1, CONV_DIM).astype(z.dtype)
    zc = lax.conv_general_dilated(z, rhs, window_strides=(1,), padding=[(CONV_WIDTH - 1, 0)],
                                  dimension_numbers=('NWC', 'WIO', 'NWC'),
                                  feature_group_count=CONV_DIM)
    return b_gate * (zc + conv_b)


def hier_moe(h, w_rg, b_rg, w_re, b_re, w_gate, w_up, w_down):
    B, S, D = h.shape
    T = B * S
    hf = h.reshape(T, D)
    g_logits = (hf @ w_rg + b_rg).astype(jnp.float32)
    g_prob = jax.nn.softmax(g_logits, axis=-1)
    g_idx = jnp.argmax(g_logits, axis=-1)
    p_group = jnp.take_along_axis(g_prob, g_idx[:, None], axis=1)[:, 0]
    e_logits = (hf @ w_re + b_re).astype(jnp.float32).reshape(T, N_GROUPS, EXPERTS_PER_GROUP)
    e_sel = jnp.take_along_axis(e_logits, g_idx[:, None, None], axis=1)[:, 0]
    top_v, top_i = lax.top_k(e_sel, TOP_K)
    gates = jax.nn.softmax(top_v, axis=-1) * p_group[:, None]
    expert = g_idx[:, None] * EXPERTS_PER_GROUP + top_i
    A = T * TOP_K
    flat_e = expert.reshape(A)
    flat_tok = jnp.repeat(jnp.arange(T, dtype=jnp.int32), TOP_K)
    flat_w = gates.reshape(A)
    order = jnp.argsort(flat_e)
    se, stok, sw = flat_e[order], flat_tok[order], flat_w[order]
    counts = jnp.bincount(flat_e, length=N_EXPERTS)
    starts = jnp.cumsum(counts) - counts
    padded = (counts + DISPATCH_BLOCK - 1) // DISPATCH_BLOCK * DISPATCH_BLOCK
    pend = jnp.cumsum(padded)
    pstarts = pend - padded
    dest = pstarts[se] + (jnp.arange(A) - starts[se])
    n_blocks = -(-A // DISPATCH_BLOCK) + N_EXPERTS
    R = n_blocks * DISPATCH_BLOCK
    buf_tok = jnp.full((R,), T, dtype=jnp.int32).at[dest].set(stok)
    buf_w = jnp.zeros((R,), jnp.float32).at[dest].set(sw)
    blk_e = jnp.minimum(jnp.searchsorted(pend, jnp.arange(n_blocks) * DISPATCH_BLOCK, side='right'),
                        N_EXPERTS - 1)
    h_pad = jnp.concatenate([hf, jnp.zeros((1, D), hf.dtype)], axis=0)

    def expert_block(args):
        tok, e = args
        xb = h_pad[tok]
        a = jax.nn.silu(xb @ w_gate[e]) * (xb @ w_up[e])
        return a @ w_down[e]

    out = lax.map(expert_block, (buf_tok.reshape(n_blocks, DISPATCH_BLOCK), blk_e))
    out = out.reshape(R, D) * buf_w[:, None].astype(out.dtype)
    y = jnp.zeros((T + 1, D), out.dtype).at[buf_tok].add(out)
    return y[:T].reshape(B, S, D)


def setup_inputs(seed: int = 0) -> dict:
    key = jax.random.key(seed)
    ks = jax.random.split(key, 28)
    L, D = DEPTH, D_MODEL
    f32 = jnp.float32

    def nrm(k, shape, scale):
        return jax.random.normal(k, shape, f32) * scale

    def gain(k, shape):
        return 1.0 + 0.02 * jax.random.normal(k, shape, f32)

    offsets = jax.random.randint(ks[2], (BATCH, 1), 0, 4096, dtype=jnp.int32)
    positions = offsets + jnp.arange(SEQ, dtype=jnp.int32)[None, :]
    return {
        'x': jax.random.normal(ks[0], (BATCH, SEQ, D), f32),
        'c': jax.random.normal(ks[1], (BATCH, D), f32),
        'positions': positions,
        'w_ada': nrm(ks[3], (L, D, N_MOD * D), 0.3 * D ** -0.5),
        'b_ada': nrm(ks[4], (L, N_MOD * D), 0.02),
        'norm1_g': gain(ks[5], (L, D)),
        'w_in': nrm(ks[6], (L, D, IN_COLS), D ** -0.5),
        'q_norm_g': gain(ks[7], (L, Q_LORA_RANK)),
        'kv_norm_g': gain(ks[8], (L, KV_LORA_RANK)),
        'w_uq': nrm(ks[9], (L, Q_LORA_RANK, MLA_HEADS * (QK_NOPE_DIM + QK_ROPE_DIM)), Q_LORA_RANK ** -0.5),
        'w_uk': nrm(ks[10], (L, KV_LORA_RANK, MLA_HEADS * QK_NOPE_DIM), KV_LORA_RANK ** -0.5),
        'w_uv': nrm(ks[11], (L, KV_LORA_RANK, MLA_HEADS * V_HEAD_DIM), KV_LORA_RANK ** -0.5),
        'conv_w': nrm(ks[12], (L, CONV_WIDTH, CONV_DIM), CONV_WIDTH ** -0.5),
        'conv_b': nrm(ks[13], (L, CONV_DIM), 0.02),
        'attn_out_g': gain(ks[14], (L, ATTN_WIDTH)),
        'conv_out_g': gain(ks[15], (L, CONV_DIM)),
        'w_out': nrm(ks[16], (L, MIX_WIDTH, D), MIX_WIDTH ** -0.5),
        'norm2_g': gain(ks[17], (L, D)),
        'w_router_group': nrm(ks[18], (L, D, N_GROUPS), D ** -0.5),
        'b_router_group': nrm(ks[19], (L, N_GROUPS), 0.01),
        'w_router_expert': nrm(ks[20], (L, D, N_EXPERTS), D ** -0.5),
        'b_router_expert': nrm(ks[21], (L, N_EXPERTS), 0.01),
        'w_exp_gate': nrm(ks[22], (L, N_EXPERTS, D, D_EXPERT), D ** -0.5),
        'w_exp_up': nrm(ks[23], (L, N_EXPERTS, D, D_EXPERT), D ** -0.5),
        'w_exp_down': nrm(ks[24], (L, N_EXPERTS, D_EXPERT, D), D_EXPERT ** -0.5),
        'final_g': gain(ks[25], (D,)),
    }


def reference(x, c, positions, w_ada, b_ada, norm1_g, w_in, q_norm_g, kv_norm_g, w_uq, w_uk, w_uv,
              conv_w, conv_b, attn_out_g, conv_out_g, w_out, norm2_g, w_router_group, b_router_group,
              w_router_expert, b_router_expert, w_exp_gate, w_exp_up, w_exp_down, final_g):
    c_act = jax.nn.silu(c)
    for l in range(DEPTH):
        mod = c_act @ w_ada[l] + b_ada[l]
        sh1, sc1, g1, sh2, sc2, g2 = jnp.split(mod, N_MOD, axis=-1)
        h = modulate(rms_norm(x, norm1_g[l]), sh1, sc1)
        proj = h @ w_in[l]
        q_c, kv_c, k_r, u, b_gate, c_gate = jnp.split(proj, IN_OFFSETS, axis=-1)
        attn = mla_mixer(q_c, kv_c, k_r, positions, q_norm_g[l], kv_norm_g[l], w_uq[l], w_uk[l], w_uv[l])
        conv = short_conv_mixer(u, b_gate, c_gate, conv_w[l], conv_b[l])
        mixed = jnp.concatenate([rms_norm(attn, attn_out_g[l]), rms_norm(conv, conv_out_g[l])], axis=-1)
        x = x + g1[:, None, :] * (mixed @ w_out[l])
        h2 = modulate(rms_norm(x, norm2_g[l]), sh2, sc2)
        x = x + g2[:, None, :] * hier_moe(h2, w_router_group[l], b_router_group[l], w_router_expert[l],
                                          b_router_expert[l], w_exp_gate[l], w_exp_up[l], w_exp_down[l])
    return rms_norm(x, final_g)
```

```cpp
#include <hip/hip_runtime.h>
#include <cstdio>
#include <cstdint>
namespace nv {
constexpr int T = 32768, D = 1024, B_ = 16, S = 2048, NP = 1952;
constexpr float EPS = 1e-6f;

__device__ __forceinline__ float wsum(float v) {
#pragma unroll
    for (int o = 32; o > 0; o >>= 1) v += __shfl_xor(v, o);
    return v;
}
__device__ __forceinline__ float silu(float a) { return a / (1.f + expf(-a)); }

__global__ void k_mod(const float* c, const float* w_ada, const float* b_ada, float* mod) {
    int n = blockIdx.x * 256 + threadIdx.x, b = blockIdx.y;
    float acc = 0.f;
    for (int k = 0; k < D; ++k) acc += silu(c[b * D + k]) * w_ada[(size_t)k * 6144 + n];
    mod[b * 6144 + n] = acc + b_ada[n];
}
__global__ void k_normmod(const float* x, const float* g, const float* mod, int sh_off, int sc_off, float* h) {
    int row = blockIdx.x * 4 + (threadIdx.x >> 6), lane = threadIdx.x & 63, b = row / S;
    const float* xr = x + (size_t)row * D;
    float v[16], ss = 0.f;
#pragma unroll
    for (int j = 0; j < 16; ++j) { v[j] = xr[lane + 64 * j]; ss += v[j] * v[j]; }
    float r = rsqrtf(wsum(ss) / D + EPS);
#pragma unroll
    for (int j = 0; j < 16; ++j) { int k = lane + 64 * j; h[(size_t)row * D + k] = v[j] * r * g[k] * (1.f + mod[b * 6144 + sc_off + k]) + mod[b * 6144 + sh_off + k]; }
}
__global__ void k_gemm(const float* A, int lda, const float* Bm, int ldb, float* C, int ldc, int M, int N, int K, int mode, const float* R, const float* gv) {
    __shared__ float As[16][65], Bs[16][65];
    int tx = threadIdx.x & 15, ty = threadIdx.x >> 4, m0 = blockIdx.y * 64, n0 = blockIdx.x * 64;
    float acc[4][4] = {};
    for (int k0 = 0; k0 < K; k0 += 16) {
        for (int i = threadIdx.x; i < 1024; i += 256) { int r = i >> 4, kk = i & 15; As[kk][r] = A[(size_t)(m0 + r) * lda + k0 + kk]; }
        for (int i = threadIdx.x; i < 1024; i += 256) { int kk = i >> 6, cc = i & 63; Bs[kk][cc] = (n0 + cc < N) ? Bm[(size_t)(k0 + kk) * ldb + n0 + cc] : 0.f; }
        __syncthreads();
#pragma unroll
        for (int kk = 0; kk < 16; ++kk) {
            float a[4], b[4];
#pragma unroll
            for (int i = 0; i < 4; ++i) { a[i] = As[kk][ty * 4 + i]; b[i] = Bs[kk][tx * 4 + i]; }
#pragma unroll
            for (int i = 0; i < 4; ++i)
#pragma unroll
                for (int j = 0; j < 4; ++j) acc[i][j] += a[i] * b[j];
        }
        __syncthreads();
    }
    for (int i = 0; i < 4; ++i) for (int j = 0; j < 4; ++j) {
        int m = m0 + ty * 4 + i, n = n0 + tx * 4 + j;
        if (n < N) { float v = acc[i][j]; if (mode == 1) v = R[(size_t)m * ldc + n] + gv[(m / S) * 6144 + n] * v; C[(size_t)m * ldc + n] = v; }
    }
}
__global__ void k_rms_inplace(float* p, int ld, int ncols, const float* g) {
    int row = blockIdx.x * 4 + (threadIdx.x >> 6), lane = threadIdx.x & 63;
    float* pr = p + (size_t)row * ld; float ss = 0.f;
    for (int k = lane; k < ncols; k += 64) ss += pr[k] * pr[k];
    float r = rsqrtf(wsum(ss) / ncols + EPS);
    for (int k = lane; k < ncols; k += 64) pr[k] = pr[k] * r * g[k];
}
__global__ void k_rope(float* q, const float* proj, float* kr, const int* pos) {
    int t = blockIdx.x, i = threadIdx.x & 15, hh = threadIdx.x >> 4;
    float invf = 1.0f / powf(10000.0f, (float)(2 * i) / 32.0f);
    float ang = (float)pos[t] * invf, cs = cosf(ang), sn = sinf(ang);
    if (hh < 8) { float* p = q + (size_t)t * 768 + hh * 96 + 64; float x1 = p[i], x2 = p[16 + i]; p[i] = x1 * cs - x2 * sn; p[16 + i] = x2 * cs + x1 * sn; }
    else { const float* p = proj + (size_t)t * NP + 384; float x1 = p[i], x2 = p[16 + i]; kr[t * 32 + i] = x1 * cs - x2 * sn; kr[t * 32 + 16 + i] = x2 * cs + x1 * sn; }
}
__global__ void k_attn(const float* q, const float* kn, const float* v, const float* kr, float* mixed) {
    __shared__ float sc[4][2048]; __shared__ float qs[4][96];
    int w = threadIdx.x >> 6, lane = threadIdx.x & 63;
    int id = blockIdx.x * 4 + w;
    int qi = id % S, h = (id / S) % 8, b = id / (S * 8);
    int t = b * S + qi; int nk = (qi / 64 + 1) * 64;
    for (int d = lane; d < 96; d += 64) qs[w][d] = q[(size_t)t * 768 + h * 96 + d];
    __syncthreads();
    float mx = -1e30f;
    for (int j = lane; j < nk; j += 64) {
        const float* kp = kn + (size_t)(b * S + j) * 512 + h * 64; const float* rp = kr + (size_t)(b * S + j) * 32;
        float s = 0.f;
        for (int d = 0; d < 64; ++d) s += qs[w][d] * kp[d];
        for (int d = 0; d < 32; ++d) s += qs[w][64 + d] * rp[d];
        s *= 0.10206207261596575f;
        sc[w][j] = s; mx = fmaxf(mx, s);
    }
#pragma unroll
    for (int o = 32; o > 0; o >>= 1) mx = fmaxf(mx, __shfl_xor(mx, o));
    float sum = 0.f;
    for (int j = lane; j < nk; j += 64) { float p = expf(sc[w][j] - mx); sc[w][j] = p; sum += p; }
    sum = wsum(sum);
    __syncthreads();
    float o = 0.f;
    for (int j = 0; j < nk; ++j) o += sc[w][j] * v[(size_t)(b * S + j) * 512 + h * 64 + lane];
    mixed[(size_t)t * 1024 + h * 64 + lane] = o / sum;
}
__global__ void k_conv(const float* proj, const float* cw, const float* cb, const float* g, float* mixed) {
    __shared__ float red[4];
    int t = blockIdx.x, s = t % S; float val[2], ss = 0.f;
    for (int j = 0; j < 2; ++j) { int ch = threadIdx.x + 256 * j; float zc = 0.f;
        for (int w = 0; w < 3; ++w) { int ts = s + w - 2; if (ts >= 0) { const float* pr = proj + (size_t)(t + w - 2) * NP; zc += pr[1440 + ch] * pr[416 + ch] * cw[w * 512 + ch]; } }
        val[j] = proj[(size_t)t * NP + 928 + ch] * (zc + cb[ch]); ss += val[j] * val[j]; }
    ss = wsum(ss); if ((threadIdx.x & 63) == 0) red[threadIdx.x >> 6] = ss; __syncthreads();
    float r = rsqrtf((red[0] + red[1] + red[2] + red[3]) / 512.f + EPS);
    for (int j = 0; j < 2; ++j) { int ch = threadIdx.x + 256 * j; mixed[(size_t)t * 1024 + 512 + ch] = val[j] * r * g[ch]; }
}
__global__ void k_route(const float* h2, const float* wrg, const float* brg, const float* wre, const float* bre, int* ri, float* rw) {
    int row = blockIdx.x * 4 + (threadIdx.x >> 6), lane = threadIdx.x & 63;
    const float* hr = h2 + (size_t)row * D; float hv[16];
#pragma unroll
    for (int j = 0; j < 16; ++j) hv[j] = hr[lane + 64 * j];
    float gl[4], el[32];
    for (int e = 0; e < 4; ++e) { float a = 0.f;
#pragma unroll
        for (int j = 0; j < 16; ++j) a += hv[j] * wrg[(size_t)(lane + 64 * j) * 4 + e];
        gl[e] = wsum(a) + brg[e]; }
    for (int e = 0; e < 32; ++e) { float a = 0.f;
#pragma unroll
        for (int j = 0; j < 16; ++j) a += hv[j] * wre[(size_t)(lane + 64 * j) * 32 + e];
        el[e] = wsum(a) + bre[e]; }
    if (lane == 0) {
        int gi = 0; for (int e = 1; e < 4; ++e) if (gl[e] > gl[gi]) gi = e;
        float se = 0.f; for (int e = 0; e < 4; ++e) se += expf(gl[e] - gl[gi]);
        float pg = 1.f / se;
        int i0 = 0; for (int e = 1; e < 8; ++e) if (el[gi * 8 + e] > el[gi * 8 + i0]) i0 = e;
        int i1 = -1; for (int e = 0; e < 8; ++e) if (e != i0 && (i1 < 0 || el[gi * 8 + e] > el[gi * 8 + i1])) i1 = e;
        float v0 = el[gi * 8 + i0], v1 = el[gi * 8 + i1]; float e1 = expf(v1 - v0); float w0 = 1.f / (1.f + e1), w1 = e1 / (1.f + e1);
        ri[row * 2] = gi * 8 + i0; ri[row * 2 + 1] = gi * 8 + i1; rw[row * 2] = w0 * pg; rw[row * 2 + 1] = w1 * pg;
    }
}
__global__ void k_moe_final(const float* x1, const float* h2, const int* ri, const float* rw, const float* wg, const float* wu, const float* wd,
                            const float* mod, const float* fg, float* out) {
    __shared__ float hs[1024]; __shared__ float act[256]; __shared__ float red[4];
    int t = blockIdx.x, b = t / S, tid = threadIdx.x;
    for (int k = tid; k < 1024; k += 256) hs[k] = h2[(size_t)t * D + k];
    float y[4] = {0.f, 0.f, 0.f, 0.f};
    for (int kk = 0; kk < 2; ++kk) {
        int e = ri[t * 2 + kk]; float w = rw[t * 2 + kk];
        __syncthreads();
        const float* g_ = wg + (size_t)e * 1024 * 256; const float* u_ = wu + (size_t)e * 1024 * 256;
        float a = 0.f, u = 0.f;
        for (int k = 0; k < 1024; ++k) { a += hs[k] * g_[(size_t)k * 256 + tid]; u += hs[k] * u_[(size_t)k * 256 + tid]; }
        act[tid] = silu(a) * u;
        __syncthreads();
        const float* d_ = wd + (size_t)e * 256 * 1024;
        for (int i = 0; i < 4; ++i) { float o = 0.f; for (int j = 0; j < 256; ++j) o += act[j] * d_[(size_t)j * 1024 + tid + 256 * i]; y[i] += w * o; }
    }
    float xv[4], ss = 0.f;
    for (int i = 0; i < 4; ++i) { int n = tid + 256 * i; xv[i] = x1[(size_t)t * D + n] + mod[b * 6144 + 5 * 1024 + n] * y[i]; ss += xv[i] * xv[i]; }
    ss = wsum(ss); if ((tid & 63) == 0) red[tid >> 6] = ss; __syncthreads();
    float r = rsqrtf((red[0] + red[1] + red[2] + red[3]) / 1024.f + EPS);
    for (int i = 0; i < 4; ++i) { int n = tid + 256 * i; out[(size_t)t * D + n] = xv[i] * r * fg[n]; }
}

constexpr size_t MB = 1u << 20;
inline void run(void* const* d_in, float* out, char* ws, hipStream_t st) {
    const float* x = (const float*)d_in[0]; const float* c = (const float*)d_in[1]; const int* pos = (const int*)d_in[2];
    const float* w_ada = (const float*)d_in[3]; const float* b_ada = (const float*)d_in[4]; const float* n1g = (const float*)d_in[5];
    const float* w_in = (const float*)d_in[6]; const float* qng = (const float*)d_in[7]; const float* kvng = (const float*)d_in[8];
    const float* w_uq = (const float*)d_in[9]; const float* w_uk = (const float*)d_in[10]; const float* w_uv = (const float*)d_in[11];
    const float* cw = (const float*)d_in[12]; const float* cb = (const float*)d_in[13]; const float* aog = (const float*)d_in[14]; const float* cog = (const float*)d_in[15];
    const float* w_out = (const float*)d_in[16]; const float* n2g = (const float*)d_in[17];
    const float* wrg = (const float*)d_in[18]; const float* brg = (const float*)d_in[19]; const float* wre = (const float*)d_in[20]; const float* bre = (const float*)d_in[21];
    const float* wg = (const float*)d_in[22]; const float* wu = (const float*)d_in[23]; const float* wd = (const float*)d_in[24]; const float* fg = (const float*)d_in[25];
    float* mod = (float*)ws; float* proj = (float*)(ws + 1 * MB); float* h = (float*)(ws + 257 * MB); float* q = h;
    float* kn = (float*)(ws + 358 * MB); float* v = (float*)(ws + 425 * MB); float* kr = (float*)(ws + 492 * MB);
    float* x1 = proj; float* h2 = (float*)(ws + 135 * MB); int* ri = (int*)(ws + 269 * MB); float* rw = (float*)(ws + 270 * MB);
    float* mixed = out;
    k_mod<<<dim3(24, 16), 256, 0, st>>>(c, w_ada, b_ada, mod);
    k_normmod<<<T / 4, 256, 0, st>>>(x, n1g, mod, 0, 1024, h);
    k_gemm<<<dim3((NP + 63) / 64, T / 64), 256, 0, st>>>(h, D, w_in, NP, proj, NP, T, NP, D, 0, nullptr, nullptr);
    k_rms_inplace<<<T / 4, 256, 0, st>>>(proj, NP, 256, qng);
    k_rms_inplace<<<T / 4, 256, 0, st>>>(proj + 256, NP, 128, kvng);
    k_gemm<<<dim3(768 / 64, T / 64), 256, 0, st>>>(proj, NP, w_uq, 768, q, 768, T, 768, 256, 0, nullptr, nullptr);
    k_gemm<<<dim3(512 / 64, T / 64), 256, 0, st>>>(proj + 256, NP, w_uk, 512, kn, 512, T, 512, 128, 0, nullptr, nullptr);
    k_gemm<<<dim3(512 / 64, T / 64), 256, 0, st>>>(proj + 256, NP, w_uv, 512, v, 512, T, 512, 128, 0, nullptr, nullptr);
    k_rope<<<T, 144, 0, st>>>(q, proj, kr, pos);
    k_conv<<<T, 256, 0, st>>>(proj, cw, cb, cog, mixed);
    k_attn<<<B_ * 8 * S / 4, 256, 0, st>>>(q, kn, v, kr, mixed);
    k_rms_inplace<<<T / 4, 256, 0, st>>>(mixed, 1024, 512, aog);
    k_gemm<<<dim3(1024 / 64, T / 64), 256, 0, st>>>(mixed, 1024, w_out, 1024, x1, 1024, T, 1024, 1024, 1, x, mod + 2048);
    k_normmod<<<T / 4, 256, 0, st>>>(x1, n2g, mod, 3 * 1024, 4 * 1024, h2);
    k_route<<<T / 4, 256, 0, st>>>(h2, wrg, brg, wre, bre, ri, rw);
    k_moe_final<<<T, 256, 0, st>>>(x1, h2, ri, rw, wg, wu, wd, mod, fg, out);
}
}
extern "C" void kernel_launch(void* const* d_in, const int* in_sizes, int n_in, void* d_out, int out_size, void* d_ws, size_t ws_size, hipStream_t stream) {
    nv::run(d_in, (float*)d_out, (char*)d_ws, stream);
}
```

```cpp
#include <hip/hip_runtime.h>
#include <cstdio>
#include <cstdint>
#define MK_DEBUG 0
#define GAS __attribute__((address_space(1)))
#define LAS __attribute__((address_space(3)))
typedef unsigned short bf16;
typedef unsigned short bf16_t;
typedef short bf16x8 __attribute__((ext_vector_type(8)));
typedef short s16x4 __attribute__((ext_vector_type(4)));
typedef float f32x4 __attribute__((ext_vector_type(4)));
typedef float f32x2 __attribute__((ext_vector_type(2)));
typedef float f32x16 __attribute__((ext_vector_type(16)));
typedef unsigned u32x4 __attribute__((ext_vector_type(4)));
typedef unsigned u32x2 __attribute__((ext_vector_type(2)));

constexpr int T = 32768, DM = 1024, NB = 16, SEQ = 2048;
constexpr float RMS_EPS = 1e-6f;
constexpr float QSCALE = 0.10206207261596575f * 1.4426950408889634f;
constexpr int NEXP = 32, LIST_CAP = 65536;
constexpr int ACT_ROWS = 65536 + 32 * 256;

constexpr size_t MiB = 1u << 20;
constexpr size_t WS_CTL = 0;
constexpr size_t WS_MOD = 1 * MiB;
constexpr size_t ZERO_BYTES = 2 * MiB;
constexpr size_t WS_ROPE = 2 * MiB;
constexpr size_t WS_WIN = 6 * MiB;
constexpr size_t WS_WUQ = 10 * MiB;
constexpr size_t WS_WUKV = 10 * MiB + 512 * 1024;
constexpr size_t WS_WOUT = 11 * MiB;
constexpr size_t WS_WGU = 13 * MiB;
constexpr size_t WS_WD = 45 * MiB;
constexpr size_t WS_SSQQ = 61 * MiB;
constexpr size_t WS_SSQKV = 61 * MiB + 512 * 1024;
constexpr size_t WS_SSQA = 62 * MiB;
constexpr size_t WS_LTOK = 63 * MiB;
constexpr size_t WS_LW = 71 * MiB;
constexpr size_t WS_ROUTE = 79 * MiB;
constexpr size_t WS_H = 80 * MiB;
constexpr size_t WS_QC = 144 * MiB;
constexpr size_t WS_KVX = 160 * MiB;
constexpr size_t WS_Z = 176 * MiB;
constexpr size_t WS_BG = 208 * MiB;
constexpr size_t WS_Q = 240 * MiB;
constexpr size_t WS_K = 288 * MiB;
constexpr size_t WS_V = 320 * MiB;
constexpr size_t WS_KR = 352 * MiB;
constexpr size_t WS_ACT = 144 * MiB;
constexpr size_t WS_Y = 180 * MiB;
constexpr size_t WS_X1DBG = 360 * MiB;
constexpr size_t WS_END = 488 * MiB;
constexpr int CW_CNT = 64;
constexpr int CW_ERR = 256;
constexpr int CW_BAR = 4096;

__device__ __forceinline__ unsigned f2bf(float f) { unsigned u = __builtin_bit_cast(unsigned, f); return (u + 0x7fffu + ((u >> 16) & 1u)) >> 16; }
__device__ __forceinline__ unsigned pk2(float lo, float hi) { return f2bf(lo) | (f2bf(hi) << 16); }
__device__ __forceinline__ float bf2f(unsigned short b) { return __builtin_bit_cast(float, (unsigned)b << 16); }
__device__ __forceinline__ float wave_sum(float v) {
#pragma unroll
    for (int o = 32; o > 0; o >>= 1) v += __shfl_xor(v, o);
    return v;
}
__device__ __forceinline__ float silu_f(float a) { return a / (1.f + __expf(-a)); }
#define LDS_WAIT() asm volatile("s_waitcnt lgkmcnt(0)" ::: "memory")
#define VM_WAIT() asm volatile("s_waitcnt vmcnt(0)" ::: "memory")
namespace pg8 {
#define PG8_LAS __attribute__((address_space(3)))
constexpr int BM = 256, BK = 64, HALF = 128, HTB = HALF * BK * 2, STAGE_BYTES = 8 * HTB, NXCD = 8, WGM = 8;
__host__ __device__ __forceinline__ int lds_byte(int r, int c) { const int st = (r >> 4) * 2 + (c >> 5), rr = r & 15, cc = c & 31, ob = rr * 64 + cc * 2; return st * 1024 + (ob ^ (((ob >> 9) & 1) << 5)); }
__host__ __device__ __forceinline__ void stage_rc(int b, int& R, int& C) { const int st = b / 1024, sb = b % 1024, swz = sb ^ (((sb >> 9) & 1) << 5); R = (st >> 1) * 16 + swz / 64; C = (st & 1) * 32 + (swz % 64) / 2; }
__host__ __device__ __forceinline__ int perm32(int rho) { const int n = rho >> 4, i = rho & 15; return 8 * (i >> 2) + 4 * n + (i & 3); }

struct Unit { int pm, pn, e, r0; };
struct Gemm { const bf16_t* A; const bf16_t* Bt; int K; };

struct StaticOrder {
    int nM, nN, nwg, G, c;
    __device__ void init(int M, int N, int G_, int c_) { nM = M / BM; nN = N / BM; nwg = nM * nN; G = G_; c = c_; }
    __device__ bool next(int i, Unit& u) const {
        const long L = (long)i * G + c; if (L >= nwg) return false;
        int wgid = (int)L; { const int q = nwg / NXCD, r = nwg % NXCD, xcd = wgid % NXCD, off = wgid / NXCD; wgid = (xcd < r ? xcd * (q + 1) : r * (q + 1) + (xcd - r) * q) + off; }
        const int nig = WGM * nN, gid = wgid / nig, fm = gid * WGM, gsz = (nM - fm) < WGM ? (nM - fm) : WGM;
        u.pm = fm + ((wgid % nig) % gsz); u.pn = (wgid % nig) / gsz; u.e = 0; u.r0 = 0; return true;
    }
    static constexpr bool GATHER = false;
    __device__ __forceinline__ int arow(const Unit& u, int rloc) const { return u.pm * BM + rloc; }
};

__device__ __forceinline__ unsigned cvt_pk_bf16(float lo, float hi) { unsigned r; asm volatile("v_cvt_pk_bf16_f32 %0, %1, %2" : "=v"(r) : "v"(lo), "v"(hi)); return r; }

template <class Epi, class Sched, bool ALIGN_EPI>
__device__ __forceinline__ void gemm_phase(PG8_LAS unsigned char* lds, const Gemm g, const Sched& S, const Epi& E) {
    const int tid = threadIdx.x, wid = __builtin_amdgcn_readfirstlane(tid >> 6), lane = tid & 63, wr = wid >> 2, wc = wid & 3, fr = lane & 15, fq = lane >> 4;
    const int K = g.K, nt = K / BK;
    unsigned voffA[2], voffB[2];
#pragma unroll
    for (int i = 0; i < 2; ++i) { int R, C; stage_rc(tid * 16 + i * 8192, R, C); const int Rb = Epi::PERM ? ((R & ~31) + perm32(R & 31)) : R;
        voffA[i] = (unsigned)(R * K + C) * 2u; voffB[i] = (unsigned)(Rb * K + C) * 2u; }
    const size_t kstep = (size_t)(BK * 2);
    const size_t hstep = (size_t)HALF * K * 2;
    const size_t tstep = 2 * hstep;
    const unsigned ldsw = (unsigned)wid * 1024u;
    const int aoff = lds_byte(wr * 64 + fr, fq * 8), boff = lds_byte(wc * 32 + fr, fq * 8);
#define PG8_SA(b, h) (((b) * 2 + (h)) * HTB)
#define PG8_SB(b, h) ((4 + (b) * 2 + (h)) * HTB)
#define PG8_STAGE(bufoff, gbase, voff) do { _Pragma("unroll") for (int _i = 0; _i < 2; ++_i) \
        __builtin_amdgcn_global_load_lds((const unsigned*)((const char*)(gbase) + (voff)[_i]), (PG8_LAS unsigned*)(lds + (bufoff) + ldsw + _i * 8192), 16, 0, 0); } while (0)
#define PG8_STAGE_A(bufoff, h, kb, usenext) do { _Pragma("unroll") for (int _i = 0; _i < 2; ++_i) { const char* _p; \
        if constexpr (Sched::GATHER) _p = (const char*)g.A + (size_t)(kb) + ((usenext) ? nvA[h][_i] : vA[h][_i]); \
        else _p = ((usenext) ? nA : cA) + (size_t)(kb) + (size_t)(h) * hstep + voffA[_i]; \
        __builtin_amdgcn_global_load_lds((const unsigned*)_p, (PG8_LAS unsigned*)(lds + (bufoff) + ldsw + _i * 8192), 16, 0, 0); } } while (0)
#define PG8_LDA(dst, b, h) do { _Pragma("unroll") for (int m = 0; m < 4; ++m) _Pragma("unroll") for (int k = 0; k < 2; ++k) dst[m][k] = *(const PG8_LAS bf16x8*)(lds + PG8_SA(b, h) + aoff + m * 2048 + k * 1024); } while (0)
#define PG8_LDB(dst, b, h) do { _Pragma("unroll") for (int n = 0; n < 2; ++n) _Pragma("unroll") for (int k = 0; k < 2; ++k) dst[n][k] = *(const PG8_LAS bf16x8*)(lds + PG8_SB(b, h) + boff + n * 2048 + k * 1024); } while (0)
#define PG8_MMA(ai, bj, At, Bt) do { __builtin_amdgcn_s_setprio(1); _Pragma("unroll") for (int m = 0; m < 4; ++m) _Pragma("unroll") for (int n = 0; n < 2; ++n) _Pragma("unroll") for (int k = 0; k < 2; ++k) \
        acc[ai][bj][m][n] = __builtin_amdgcn_mfma_f32_16x16x32_bf16(Bt[n][k], At[m][k], acc[ai][bj][m][n], 0, 0, 0); __builtin_amdgcn_s_setprio(0); } while (0)
#define PG8_WAIT_V(n) asm volatile("s_waitcnt vmcnt(" #n ")" ::: "memory")
#define PG8_WAIT_L(n) asm volatile("s_waitcnt lgkmcnt(" #n ")" ::: "memory")
#define PG8_BAR __builtin_amdgcn_s_barrier()
#define PG8_SCHED __builtin_amdgcn_sched_barrier(0)
#define PG8_SETVO(vo, u) do { _Pragma("unroll") for (int _i = 0; _i < 2; ++_i) { int R_, C_; stage_rc(tid * 16 + _i * 8192, R_, C_); \
        _Pragma("unroll") for (int _h = 0; _h < 2; ++_h) vo[_h][_i] = ((unsigned)S.arow(u, _h * HALF + R_) * (unsigned)K + (unsigned)C_) * 2u; } } while (0)
    Unit cur, nxt; int ui = 0;
    if (!S.next(0, cur)) return;
    f32x4 acc[2][2][4][2];
#pragma unroll
    for (int a = 0; a < 2; ++a)
#pragma unroll
        for (int b = 0; b < 2; ++b)
#pragma unroll
            for (int m = 0; m < 4; ++m)
#pragma unroll
                for (int n = 0; n < 2; ++n) acc[a][b][m][n] = (f32x4){0.f, 0.f, 0.f, 0.f};
    bf16x8 At[4][2], B0[2][2], B1[2][2];
    unsigned vA[2][2], nvA[2][2];
    const char* cA = (const char*)g.A; const char* nA = cA;
    if constexpr (Sched::GATHER) { PG8_SETVO(vA, cur); } else { cA = (const char*)g.A + (size_t)S.arow(cur, 0) * K * 2; }
    const char* cB = (const char*)g.Bt + (size_t)cur.pn * tstep;
    PG8_STAGE(PG8_SB(0, 0), cB, voffB); PG8_STAGE(PG8_SB(0, 1), cB + hstep, voffB); PG8_STAGE_A(PG8_SA(0, 0), 0, 0, false); PG8_STAGE_A(PG8_SA(0, 1), 1, 0, false);
    if (wr == 1) PG8_BAR;
    PG8_WAIT_V(2); PG8_BAR;
    PG8_STAGE(PG8_SB(1, 0), cB + kstep, voffB); PG8_STAGE_A(PG8_SA(1, 0), 0, kstep, false); PG8_STAGE(PG8_SB(1, 1), cB + hstep + kstep, voffB);
    PG8_WAIT_V(6); PG8_BAR;
    for (;;) {
        const bool has_next = S.next(ui + 1, nxt);
        if constexpr (Sched::GATHER) {
            if (has_next) { PG8_SETVO(nvA, nxt); } else {
#pragma unroll
                for (int _h = 0; _h < 2; ++_h)
#pragma unroll
                    for (int _i = 0; _i < 2; ++_i) nvA[_h][_i] = vA[_h][_i]; }
        } else { nA = has_next ? (const char*)g.A + (size_t)S.arow(nxt, 0) * K * 2 : cA; }
        const char* nB = has_next ? (const char*)g.Bt + (size_t)nxt.pn * tstep : cB;
#pragma nounroll
        for (int t = 0; t < nt; t += 2) {
            const bool last = (t == nt - 2);
            if constexpr (Epi::HAS_MID) { if (t == Epi::MID_T) E.mid(acc, cur, wr, wc, fr, fq); }
            const size_t k1 = (size_t)(t + 1) * kstep;
            const size_t k2 = last ? 0 : (size_t)(t + 2) * kstep, k3 = k2 + kstep;
            const char* b2 = last ? nB : cB + (size_t)(t + 2) * kstep; const char* b3 = b2 + kstep;
            PG8_LDB(B0, 0, 0); PG8_LDB(B1, 0, 1); PG8_SCHED; PG8_LDA(At, 0, 0); PG8_STAGE_A(PG8_SA(1, 1), 1, k1, false);
            PG8_WAIT_V(8); PG8_WAIT_L(0); PG8_BAR; PG8_MMA(0, 0, At, B0); PG8_MMA(0, 1, At, B1); PG8_BAR; PG8_SCHED;
            PG8_LDA(At, 0, 1); PG8_STAGE(PG8_SB(0, 0), b2, voffB); PG8_STAGE(PG8_SB(0, 1), b2 + hstep, voffB); PG8_STAGE_A(PG8_SA(0, 0), 0, k2, last);
            PG8_WAIT_V(8); PG8_WAIT_L(0); PG8_BAR; PG8_MMA(1, 0, At, B0); PG8_MMA(1, 1, At, B1); PG8_BAR; PG8_SCHED;
            PG8_LDB(B0, 1, 0); PG8_LDB(B1, 1, 1); PG8_SCHED; PG8_LDA(At, 1, 0); PG8_STAGE_A(PG8_SA(0, 1), 1, k2, last);
            PG8_WAIT_V(8); PG8_WAIT_L(0); PG8_BAR; PG8_MMA(0, 0, At, B0); PG8_MMA(0, 1, At, B1); PG8_BAR; PG8_SCHED;
            PG8_LDA(At, 1, 1); PG8_STAGE(PG8_SB(1, 0), b3, voffB); PG8_STAGE(PG8_SB(1, 1), b3 + hstep, voffB); PG8_STAGE_A(PG8_SA(1, 0), 0, k3, last);
            PG8_WAIT_V(8); PG8_WAIT_L(0); PG8_BAR; PG8_MMA(1, 0, At, B0); PG8_MMA(1, 1, At, B1); PG8_BAR; PG8_SCHED;
        }
        if constexpr (ALIGN_EPI) { if (wr == 0) PG8_BAR; }
        E(acc, cur, wr, wc, fr, fq);
        if (!has_next) break;
#pragma unroll
        for (int a = 0; a < 2; ++a)
#pragma unroll
            for (int b = 0; b < 2; ++b)
#pragma unroll
                for (int m = 0; m < 4; ++m)
#pragma unroll
                    for (int n = 0; n < 2; ++n) acc[a][b][m][n] = (f32x4){0.f, 0.f, 0.f, 0.f};
        cur = nxt; cB = nB; cA = nA; ++ui;
        if constexpr (Sched::GATHER) {
#pragma unroll
            for (int _h = 0; _h < 2; ++_h)
#pragma unroll
                for (int _i = 0; _i < 2; ++_i) vA[_h][_i] = nvA[_h][_i]; }
        if constexpr (ALIGN_EPI) { if (wr == 1) PG8_BAR; }
    }
    PG8_WAIT_V(0);
    if constexpr (!ALIGN_EPI) { if (wr == 0) PG8_BAR; }
    PG8_BAR;
#undef PG8_SA
#undef PG8_SB
#undef PG8_STAGE
#undef PG8_STAGE_A
#undef PG8_LDA
#undef PG8_LDB
#undef PG8_MMA
#undef PG8_WAIT_V
#undef PG8_WAIT_L
#undef PG8_BAR
#undef PG8_SCHED
#undef PG8_SETVO
}
}
#define XB_TMO      128
#define XB_XCNT(j)  (256  + 64 * (j))
#define XB_XSUB(j)  (1280 + 64 * (j))
#define XB_XGEN(j)  (2304 + 64 * (j))
#define XB_TOP      3328
#define XB_TOPGEN   3392
#define XCD_BAR_WORDS 3456
#define XB_SPIN_CAP (1u << 22)
__device__ __forceinline__ unsigned xb_ld(unsigned* p)              { return __hip_atomic_load(p, __ATOMIC_RELAXED, __HIP_MEMORY_SCOPE_AGENT); }
__device__ __forceinline__ unsigned xb_add(unsigned* p, unsigned v) { return __hip_atomic_fetch_add(p, v, __ATOMIC_RELAXED, __HIP_MEMORY_SCOPE_AGENT); }
__device__ __forceinline__ unsigned xb_xcc_id() { return (unsigned)__builtin_amdgcn_s_getreg((3 << 11) | 20) & 0xFu; }
#define XB_SPIN(cond, bar) do { unsigned _sp = 0; while (cond) { __builtin_amdgcn_s_sleep(1); \
    if ((++_sp & 255u) == 0u) { if (xb_ld(&(bar)[XB_TMO])) break; if (_sp > XB_SPIN_CAP) { atomicAdd(&(bar)[XB_TMO], 1u); break; } } } } while (0)
struct XcdBarrier { unsigned* bar; unsigned x; volatile LAS unsigned* st; };
__device__ __forceinline__ XcdBarrier xcd_barrier_post(unsigned* bar, volatile LAS unsigned* st) {
    XcdBarrier b; b.bar = bar; b.x = xb_xcc_id(); b.st = st;
    if (threadIdx.x == 0) (void)xb_add(&bar[XB_XCNT(b.x)], 1u);
    return b;
}
__device__ __forceinline__ void xcd_barrier_complete(unsigned* bar, unsigned x, unsigned& nloc, unsigned& nx) {
    const unsigned G = gridDim.x * gridDim.y * gridDim.z;
    unsigned sum, cnt, mine, sp = 0u;
    for (;;) {
        sum = 0u; cnt = 0u; mine = 0u;
#pragma unroll
        for (unsigned j = 0; j < 16; ++j) { const unsigned c = xb_ld(&bar[XB_XCNT(j)]); sum += c; cnt += (c > 0u) ? 1u : 0u; mine = (j == x) ? c : mine; }
        if (sum == G) break;
        __builtin_amdgcn_s_sleep(1);
        if ((++sp & 255u) == 0u) { if (xb_ld(&bar[XB_TMO])) break; if (sp > XB_SPIN_CAP) { atomicAdd(&bar[XB_TMO], 1u); break; } }
    }
    nloc = mine > 0u ? mine : 1u; nx = cnt > 0u ? cnt : 1u;
}
__device__ __forceinline__ void xcd_barrier(const XcdBarrier& b) {
    asm volatile("s_waitcnt vmcnt(0)" ::: "memory");
    __syncthreads();
    if (threadIdx.x == 0) {
        unsigned* bar = b.bar;
        __builtin_amdgcn_s_waitcnt(0);
        unsigned nloc = b.st[0], nx = b.st[1];
        if (nloc == 0u) { xcd_barrier_complete(bar, b.x, nloc, nx); b.st[0] = nloc; b.st[1] = nx; }
        const unsigned old = xb_add(&bar[XB_XSUB(b.x)], 1u);
        const unsigned gen = old / nloc;
        if (old + 1u == (gen + 1u) * nloc) {
            __builtin_amdgcn_fence(__ATOMIC_RELEASE, "agent");
            asm volatile("s_waitcnt vmcnt(0)" ::: "memory");
            const unsigned og = xb_add(&bar[XB_TOP], 1u);
            const unsigned tg = og / nx;
            if (og + 1u == (tg + 1u) * nx) xb_add(&bar[XB_TOPGEN], 1u);
            else XB_SPIN(xb_ld(&bar[XB_TOPGEN]) == tg, bar);
            __builtin_amdgcn_fence(__ATOMIC_ACQUIRE, "agent");
            xb_add(&bar[XB_XGEN(b.x)], 1u);
            asm volatile("s_waitcnt vmcnt(0)" ::: "memory");
        } else {
            XB_SPIN(xb_ld(&bar[XB_XGEN(b.x)]) == gen, bar);
            __builtin_amdgcn_fence(__ATOMIC_ACQUIRE, "agent");
            asm volatile("s_waitcnt vmcnt(0)" ::: "memory");
        }
    }
    __syncthreads();
}

struct MKArgs { const float* in[26]; float* xo; unsigned char* ws; int ph_lo, ph_hi; };
constexpr int NWAVES = 8, NTHR = 512;
constexpr int LDS_BYTES = 163840;
constexpr int MISC_OFF = 163840 - 512;

struct Frame {
    LAS unsigned char* lds; int tid, lane, wave, bid, G, vcu; unsigned char* ws;
};
#define INP(i) (A.in[i])

__device__ __forceinline__ void tr_item(const float* W, int ldw, int scol0, bf16* WT, int ldt, int drow0, int k0, const float* kscale, float mul, LAS float* scr, int lane) {
    if (W) {
#pragma unroll 8
        for (int i = 0; i < 32; ++i) { const int kk = 2 * i + (lane >> 5); float v = W[(size_t)(k0 + kk) * ldw + scol0 + (lane & 31)];
            if (kscale) v *= kscale[k0 + kk]; scr[kk * 33 + (lane & 31)] = v * mul; }
    } else {
#pragma unroll 8
        for (int i = 0; i < 32; ++i) { const int kk = 2 * i + (lane >> 5); scr[kk * 33 + (lane & 31)] = 0.f; }
    }
    LDS_WAIT(); asm volatile("" ::: "memory");
    const int c = lane & 7;
#pragma unroll
    for (int j = 0; j < 4; ++j) { const int n = (lane >> 3) + 8 * j; const LAS float* s = scr + (8 * c) * 33 + n;
        u32x4 o; o.x = pk2(s[0 * 33], s[1 * 33]); o.y = pk2(s[2 * 33], s[3 * 33]); o.z = pk2(s[4 * 33], s[5 * 33]); o.w = pk2(s[6 * 33], s[7 * 33]);
        *(u32x4*)(WT + (size_t)(drow0 + n) * ldt + k0 + 8 * c) = o; }
    LDS_WAIT(); asm volatile("" ::: "memory");
}
__device__ __forceinline__ int win_src(int n0) {
    if (n0 < 256) return n0;
    if (n0 < 384) return 256 + (n0 - 256);
    if (n0 < 416) return 384 + (n0 - 384);
    if (n0 < 512) return -1;
    if (n0 < 1536) { const int p = (n0 - 512) >> 8, j = (n0 - 512) & 255; return j < 128 ? 416 + 128 * p + j : 1440 + 128 * p + (j - 128); }
    return 928 + (n0 - 1536);
}
__device__ __forceinline__ void phase0(Frame& F, const MKArgs& A) {
    const float* c = INP(1); const int* pos = (const int*)INP(2); const float* w_ada = INP(3); const float* b_ada = INP(4);
    float* mod = (float*)(F.ws + WS_MOD);
    for (int it = F.bid; it < 192; it += F.G) {
        const int cg = it % 96, kh = it / 96, k0 = kh * 512;
        LAS float* cact = (LAS float*)F.lds;
        LAS float* red = (LAS float*)(F.lds + 32768);
        for (int i = F.tid; i < 16 * 512; i += NTHR) { const int b = i >> 9, k = i & 511; cact[i] = silu_f(c[b * DM + k0 + k]); }
        __syncthreads();
        float acc[16];
#pragma unroll
        for (int b = 0; b < 16; ++b) acc[b] = 0.f;
        const int n = cg * 64 + F.lane; const float* wp = w_ada + (size_t)(k0 + F.wave * 64) * 6144 + n;
#pragma unroll 8
        for (int kk = 0; kk < 64; ++kk) { const float wv = wp[(size_t)kk * 6144];
#pragma unroll
            for (int b = 0; b < 16; ++b) acc[b] += cact[b * 512 + F.wave * 64 + kk] * wv; }
#pragma unroll
        for (int b = 0; b < 16; ++b) red[(F.wave * 16 + b) * 64 + F.lane] = acc[b];
        __syncthreads();
        for (int o = F.tid; o < 1024; o += NTHR) { const int b = o >> 6, l = o & 63; float s = 0.f;
#pragma unroll
            for (int w = 0; w < 8; ++w) s += red[(w * 16 + b) * 64 + l];
            if (kh == 0) s += b_ada[cg * 64 + l];
            atomicAdd(&mod[b * 6144 + cg * 64 + l], s); }
        __syncthreads();
    }
    __syncthreads();
    LAS float* scr = (LAS float*)(F.lds + F.wave * 16384);
    const int gw = F.vcu * NWAVES + F.wave, NGW = F.G * NWAVES;
    constexpr int I_WIN = 64 * 16, I_UQ = 24 * 4, I_UKV = 32 * 4, I_OUT = 32 * 16, I_GU = 32 * 16 * 16, I_D = 32 * 32 * 4;
    constexpr int NITEMS = I_WIN + I_UQ + I_UKV + I_OUT + I_GU + I_D;
    for (int it = gw; it < NITEMS; it += NGW) {
        int r = it;
        if (r < I_WIN) { const int nb = r >> 4, kb = r & 15; const int sc = win_src(nb * 32);
            tr_item(sc >= 0 ? INP(6) : nullptr, 1952, sc, (bf16*)(F.ws + WS_WIN), 1024, nb * 32, kb * 64, nullptr, 1.f, scr, F.lane); continue; } r -= I_WIN;
        if (r < I_UQ) { const int nb = r >> 2, kb = r & 3;
            tr_item(INP(9), 768, nb * 32, (bf16*)(F.ws + WS_WUQ), 256, nb * 32, kb * 64, INP(7), QSCALE, scr, F.lane); continue; } r -= I_UQ;
        if (r < I_UKV) { const int nb = r >> 2, kb = r & 3; const float* src = kb < 2 ? (nb < 16 ? INP(10) : INP(11)) : nullptr;
            tr_item(src, 512, (nb & 15) * 32, (bf16*)(F.ws + WS_WUKV), 256, nb * 32, kb * 64, INP(8), 1.f, scr, F.lane); continue; } r -= I_UKV;
        if (r < I_OUT) { const int nb = r >> 4, kb = r & 15; const float* ks = kb < 8 ? INP(14) : INP(15) - 512;
            tr_item(INP(16), 1024, nb * 32, (bf16*)(F.ws + WS_WOUT), 1024, nb * 32, kb * 64, ks, 1.f, scr, F.lane); continue; } r -= I_OUT;
        if (r < I_GU) { const int e = r >> 8, nb = (r >> 4) & 15, kb = r & 15; const int p = nb >> 3, j0 = (nb & 7) * 32;
            const float* src = (j0 < 128 ? INP(22) : INP(23)) + (size_t)e * 1024 * 256; const int sc = 128 * p + (j0 & 127);
            tr_item(src, 256, sc, (bf16*)(F.ws + WS_WGU), 1024, e * 512 + nb * 32, kb * 64, nullptr, 1.f, scr, F.lane); continue; } r -= I_GU;
        { const int e = r >> 7, nb = (r >> 2) & 31, kb = r & 3;
            tr_item(INP(24) + (size_t)e * 256 * 1024, 1024, nb * 32, (bf16*)(F.ws + WS_WD), 256, e * 1024 + nb * 32, kb * 64, nullptr, 1.f, scr, F.lane); }
    }
    float* cs = (float*)(F.ws + WS_ROPE); float* sn = cs + (size_t)T * 16;
    for (int i = F.bid * NTHR + F.tid; i < T * 16; i += F.G * NTHR) { const int t = i >> 4, j = i & 15;
        const float invf = 1.0f / powf(10000.0f, (float)(2 * j) / 32.0f); const float ang = (float)pos[t] * invf;
        cs[i] = cosf(ang); sn[i] = sinf(ang); }
}

__device__ __forceinline__ void phase1(Frame& F, const MKArgs& A) {
    const float* x = INP(0); const float* g = INP(5); const float* mod = (const float*)(F.ws + WS_MOD);
    bf16* H = (bf16*)(F.ws + WS_H);
    LAS float* Gs = (LAS float*)F.lds; LAS float* Ss = Gs + 1024;
    for (int blk = F.bid; blk < T / 128; blk += F.G) {
        const int b = (blk * 128) / SEQ;
        __syncthreads();
        for (int k = F.tid; k < 1024; k += NTHR) { Gs[k] = g[k] * (1.f + mod[b * 6144 + 1024 + k]); Ss[k] = mod[b * 6144 + k]; }
        __syncthreads();
        for (int rr = F.wave; rr < 128; rr += NWAVES) {
            const int row = blk * 128 + rr;
            const f32x4* xr = (const f32x4*)(x + (size_t)row * DM) + F.lane;
            f32x4 v[4]; float s = 0.f;
#pragma unroll
            for (int j = 0; j < 4; ++j) { v[j] = xr[64 * j]; s += (v[j].x * v[j].x + v[j].y * v[j].y) + (v[j].z * v[j].z + v[j].w * v[j].w); }
            const float r = rsqrtf(wave_sum(s) * (1.f / DM) + RMS_EPS);
            unsigned long long* o8 = (unsigned long long*)(H + (size_t)row * DM) + F.lane;
#pragma unroll
            for (int j = 0; j < 4; ++j) { const f32x4 gg = *(const LAS f32x4*)(Gs + 4 * F.lane + 256 * j), ss = *(const LAS f32x4*)(Ss + 4 * F.lane + 256 * j);
                const f32x4 h = v[j] * r * gg + ss;
                o8[64 * j] = (unsigned long long)pk2(h.x, h.y) | ((unsigned long long)pk2(h.z, h.w) << 32); }
        }
    }
}

using pg8::Unit; using pg8::cvt_pk_bf16;
#define PK4(v0, v1) (u32x4){cvt_pk_bf16((v0)[0], (v0)[1]), cvt_pk_bf16((v0)[2], (v0)[3]), cvt_pk_bf16((v1)[0], (v1)[1]), cvt_pk_bf16((v1)[2], (v1)[3])}
__device__ __forceinline__ void rope_group(f32x4& v0, f32x4& v1, const float* cs, const float* sn, int row, int fq) {
    const int i0 = 8 * (fq & 1);
    const f32x4 c0 = *(const f32x4*)(cs + (size_t)row * 16 + i0), c1 = *(const f32x4*)(cs + (size_t)row * 16 + i0 + 4);
    const f32x4 s0 = *(const f32x4*)(sn + (size_t)row * 16 + i0), s1 = *(const f32x4*)(sn + (size_t)row * 16 + i0 + 4);
    const float sg = fq < 2 ? -1.f : 1.f;
#pragma unroll
    for (int e = 0; e < 4; ++e) { const float o0 = __shfl_xor(v0[e], 32), o1 = __shfl_xor(v1[e], 32);
        v0[e] = v0[e] * c0[e] + sg * o0 * s0[e]; v1[e] = v1[e] * c1[e] + sg * o1 * s1[e]; }
}
struct EpiP2 {
    static constexpr bool PERM = true, HAS_MID = false; static constexpr int MID_T = 0;
    bf16* qc; bf16* kvx; bf16* z; bf16* bg; bf16* kr; float* ssqq; float* ssqkv; const float* cs; const float* sn;
    __device__ __forceinline__ void mid(f32x4 (&)[2][2][4][2], const Unit&, int, int, int, int) const {}
    __device__ __forceinline__ void operator()(f32x4 (&acc)[2][2][4][2], const Unit& u, int wr, int wc, int fr, int fq) const {
        const int pn = u.pn, rowb = u.pm * 256 + wr * 64 + fr, cl = wc * 32 + 8 * fq;
        if (pn == 0) {
#pragma unroll
            for (int ai = 0; ai < 2; ++ai)
#pragma unroll
                for (int m = 0; m < 4; ++m) { const int row = rowb + ai * 128 + m * 16; float ss = 0.f;
#pragma unroll
                    for (int bj = 0; bj < 2; ++bj) { const f32x4 v0 = acc[ai][bj][m][0], v1 = acc[ai][bj][m][1];
                        ss += (v0[0] * v0[0] + v0[1] * v0[1]) + (v0[2] * v0[2] + v0[3] * v0[3]) + (v1[0] * v1[0] + v1[1] * v1[1]) + (v1[2] * v1[2] + v1[3] * v1[3]);
                        *(u32x4*)(qc + (size_t)row * 256 + bj * 128 + cl) = PK4(v0, v1); }
                    ss += __shfl_xor(ss, 16); ss += __shfl_xor(ss, 32);
                    if (fq == 0) ssqq[(size_t)row * 4 + wc] = ss; }
        } else if (pn == 1) {
#pragma unroll
            for (int ai = 0; ai < 2; ++ai)
#pragma unroll
                for (int m = 0; m < 4; ++m) { const int row = rowb + ai * 128 + m * 16;
                    f32x4 v0 = acc[ai][0][m][0], v1 = acc[ai][0][m][1];
                    float ss = (v0[0] * v0[0] + v0[1] * v0[1]) + (v0[2] * v0[2] + v0[3] * v0[3]) + (v1[0] * v1[0] + v1[1] * v1[1]) + (v1[2] * v1[2] + v1[3] * v1[3]);
                    *(u32x4*)(kvx + (size_t)row * 256 + cl) = PK4(v0, v1);
                    ss += __shfl_xor(ss, 16); ss += __shfl_xor(ss, 32);
                    if (fq == 0) ssqkv[(size_t)row * 4 + wc] = ss;
                    v0 = acc[ai][1][m][0]; v1 = acc[ai][1][m][1];
                    *(u32x4*)(kvx + (size_t)row * 256 + 128 + cl) = PK4(v0, v1);
                    if (wc == 0) { rope_group(v0, v1, cs, sn, row, fq); *(u32x4*)(kr + (size_t)row * 32 + 8 * fq) = PK4(v0, v1); }
                    asm volatile("" ::: "memory"); }
        } else if (pn < 6) {
            const int p = pn - 2;
#pragma unroll
            for (int ai = 0; ai < 2; ++ai)
#pragma unroll
                for (int m = 0; m < 4; ++m) { const int row = rowb + ai * 128 + m * 16;
                    const f32x4 v0 = acc[ai][0][m][0] * acc[ai][1][m][0], v1 = acc[ai][0][m][1] * acc[ai][1][m][1];
                    *(u32x4*)(z + (size_t)row * 512 + 128 * p + cl) = PK4(v0, v1); }
        } else {
            const int p = pn - 6;
#pragma unroll
            for (int ai = 0; ai < 2; ++ai)
#pragma unroll
                for (int m = 0; m < 4; ++m) { const int row = rowb + ai * 128 + m * 16;
#pragma unroll
                    for (int bj = 0; bj < 2; ++bj) { const f32x4 v0 = acc[ai][bj][m][0], v1 = acc[ai][bj][m][1];
                        *(u32x4*)(bg + (size_t)row * 512 + 256 * p + bj * 128 + cl) = PK4(v0, v1); } }
        }
    }
};
struct EpiQ {
    static constexpr bool PERM = true, HAS_MID = false; static constexpr int MID_T = 0;
    bf16* Q; const float* ssqq; const float* cs; const float* sn;
    __device__ __forceinline__ void mid(f32x4 (&)[2][2][4][2], const Unit&, int, int, int, int) const {}
    __device__ __forceinline__ void operator()(f32x4 (&acc)[2][2][4][2], const Unit& u, int wr, int wc, int fr, int fq) const {
        const int pn = u.pn, rowb = u.pm * 256 + wr * 64 + fr, cl = wc * 32 + 8 * fq;
#pragma unroll
        for (int ai = 0; ai < 2; ++ai)
#pragma unroll
            for (int m = 0; m < 4; ++m) { const int row = rowb + ai * 128 + m * 16;
                const f32x4 sq = *(const f32x4*)(ssqq + (size_t)row * 4);
                const float rq = rsqrtf(((sq[0] + sq[1]) + (sq[2] + sq[3])) * (1.f / 256.f) + RMS_EPS);
#pragma unroll
                for (int bj = 0; bj < 2; ++bj) { const int col32 = 8 * pn + 4 * bj + wc;
                    f32x4 v0 = acc[ai][bj][m][0] * rq, v1 = acc[ai][bj][m][1] * rq;
                    if ((col32 % 3) == 2) rope_group(v0, v1, cs, sn, row, fq);
                    *(u32x4*)(Q + (size_t)row * 768 + 256 * pn + bj * 128 + cl) = PK4(v0, v1); }
                asm volatile("" ::: "memory"); }
    }
};
struct EpiKV {
    static constexpr bool PERM = true, HAS_MID = false; static constexpr int MID_T = 0;
    bf16* Kb; bf16* Vb; const float* ssqkv;
    __device__ __forceinline__ void mid(f32x4 (&)[2][2][4][2], const Unit&, int, int, int, int) const {}
    __device__ __forceinline__ void operator()(f32x4 (&acc)[2][2][4][2], const Unit& u, int wr, int wc, int fr, int fq) const {
        const int pn = u.pn, rowb = u.pm * 256 + wr * 64 + fr, cl = wc * 32 + 8 * fq;
        bf16* dst = (pn < 2 ? Kb : Vb) + 256 * (pn & 1);
#pragma unroll
        for (int ai = 0; ai < 2; ++ai)
#pragma unroll
            for (int m = 0; m < 4; ++m) { const int row = rowb + ai * 128 + m * 16;
                const f32x4 sq = *(const f32x4*)(ssqkv + (size_t)row * 4);
                const float rk = rsqrtf(((sq[0] + sq[1]) + (sq[2] + sq[3])) * (1.f / 128.f) + RMS_EPS);
#pragma unroll
                for (int bj = 0; bj < 2; ++bj) { const f32x4 v0 = acc[ai][bj][m][0] * rk, v1 = acc[ai][bj][m][1] * rk;
                    *(u32x4*)(dst + (size_t)row * 512 + bj * 128 + cl) = PK4(v0, v1); }
                asm volatile("" ::: "memory"); }
    }
};
struct EpiOut {
    static constexpr bool PERM = false, HAS_MID = true; static constexpr int MID_T = 8;
    const float* x; const float* mod; float* xo; const float* ssqa;
    __device__ __forceinline__ void mid(f32x4 (&acc)[2][2][4][2], const Unit& u, int wr, int wc, int fr, int fq) const {
        const int rowb = u.pm * 256 + wr * 64 + fr;
#pragma unroll
        for (int ai = 0; ai < 2; ++ai)
#pragma unroll
            for (int m = 0; m < 4; ++m) { const int row = rowb + ai * 128 + m * 16;
                const f32x4 a = *(const f32x4*)(ssqa + (size_t)row * 8), b = *(const f32x4*)(ssqa + (size_t)row * 8 + 4);
                const float ra = rsqrtf((((a[0] + a[1]) + (a[2] + a[3])) + ((b[0] + b[1]) + (b[2] + b[3]))) * (1.f / 512.f) + RMS_EPS);
#pragma unroll
                for (int bj = 0; bj < 2; ++bj)
#pragma unroll
                    for (int n = 0; n < 2; ++n) acc[ai][bj][m][n] *= ra; }
    }
    __device__ __forceinline__ void operator()(f32x4 (&acc)[2][2][4][2], const Unit& u, int wr, int wc, int fr, int fq) const {
        const int rowb = u.pm * 256 + wr * 64 + fr, col0 = u.pn * 256 + wc * 32 + 4 * fq; const int b = (u.pm * 256) / SEQ;
        const float* g1 = mod + b * 6144 + 2048;
#pragma unroll
        for (int bj = 0; bj < 2; ++bj)
#pragma unroll
            for (int n = 0; n < 2; ++n) { const int col = col0 + bj * 128 + n * 16; const f32x4 gv = *(const f32x4*)(g1 + col);
#pragma unroll
                for (int ai = 0; ai < 2; ++ai)
#pragma unroll
                    for (int m = 0; m < 4; ++m) { const size_t off = (size_t)(rowb + ai * 128 + m * 16) * DM + col;
                        *(f32x4*)(xo + off) = *(const f32x4*)(x + off) + gv * acc[ai][bj][m][n]; if (m & 1) asm volatile("" ::: "memory"); } }
    }
};
struct EpiAct {
    static constexpr bool PERM = true, HAS_MID = false; static constexpr int MID_T = 0;
    bf16* act;
    __device__ __forceinline__ void mid(f32x4 (&)[2][2][4][2], const Unit&, int, int, int, int) const {}
    __device__ __forceinline__ void operator()(f32x4 (&acc)[2][2][4][2], const Unit& u, int wr, int wc, int fr, int fq) const {
        const int rowb = u.pm * 256 + wr * 64 + fr, cl = wc * 32 + 8 * fq, p = u.pn & 1;
#pragma unroll
        for (int ai = 0; ai < 2; ++ai)
#pragma unroll
            for (int m = 0; m < 4; ++m) { const int row = rowb + ai * 128 + m * 16; f32x4 v0, v1;
#pragma unroll
                for (int e = 0; e < 4; ++e) { v0[e] = silu_f(acc[ai][0][m][0][e]) * acc[ai][1][m][0][e]; v1[e] = silu_f(acc[ai][0][m][1][e]) * acc[ai][1][m][1][e]; }
                *(u32x4*)(act + (size_t)row * 256 + 128 * p + cl) = PK4(v0, v1); }
    }
};
struct EpiDown {
    static constexpr bool PERM = true, HAS_MID = false; static constexpr int MID_T = 0;
    bf16* Y; const int* ltok; const float* lw; const unsigned* cnt;
    __device__ __forceinline__ void mid(f32x4 (&)[2][2][4][2], const Unit&, int, int, int, int) const {}
    __device__ __forceinline__ void operator()(f32x4 (&acc)[2][2][4][2], const Unit& u, int wr, int wc, int fr, int fq) const {
        const int cl = wc * 32 + 8 * fq, pn = u.pn & 3; const int ce = (int)cnt[u.e];
#pragma unroll
        for (int ai = 0; ai < 2; ++ai)
#pragma unroll
            for (int m = 0; m < 4; ++m) { const int slot = u.r0 + ai * 128 + wr * 64 + m * 16 + fr;
                if (slot < ce) { const int tk = ltok[(size_t)u.e * LIST_CAP + slot]; const float w = lw[(size_t)u.e * LIST_CAP + slot];
                    bf16* dst = Y + ((size_t)(tk & 1) * T + (tk >> 1)) * DM + 256 * pn + cl;
#pragma unroll
                    for (int bj = 0; bj < 2; ++bj) { const f32x4 v0 = acc[ai][bj][m][0] * w, v1 = acc[ai][bj][m][1] * w; *(u32x4*)(dst + bj * 128) = PK4(v0, v1); } }
                asm volatile("" ::: "memory"); }
    }
};
template <bool GATHER_> struct MoeOrder {
    static constexpr bool GATHER = GATHER_;
    volatile LAS int* pb; int ntn, G, c; const unsigned* cnt; const int* ltok;
    __device__ __forceinline__ bool next(int i, Unit& u) const {
        const int L = i * G + c; const int total = pb[32] * ntn; if (L >= total) return false;
        const int rb = L / ntn, nt = L - rb * ntn; int e = 0;
        for (int j = 1; j < 32; ++j) e = (pb[j] <= rb) ? j : e;
        u.pm = rb; u.pn = e * ntn + nt; u.e = e; u.r0 = (rb - pb[e]) * 256; return true;
    }
    __device__ __forceinline__ int arow(const Unit& u, int rloc) const {
        if (!GATHER) return u.pm * 256 + rloc;
        const int slot = u.r0 + rloc; return slot < (int)cnt[u.e] ? (ltok[(size_t)u.e * LIST_CAP + slot] >> 1) : 0;
    }
};

constexpr int AT_KROW = 208, AT_KBUF = 64 * AT_KROW, AT_VBUF = 8192, AT_BUF = AT_KBUF + AT_VBUF;
__device__ __forceinline__ s16x4 vtr(const LAS unsigned char* p) { typedef short v4s __attribute__((ext_vector_type(4)));
    return __builtin_bit_cast(s16x4, __builtin_amdgcn_ds_read_tr16_b64_v4i16((LAS v4s*)p)); }
__device__ __forceinline__ void attn_unit(Frame& F, const MKArgs& A, int b, int h, int qb) {
    const bf16* Q = (const bf16*)(F.ws + WS_Q); const bf16* Kn = (const bf16*)(F.ws + WS_K); const bf16* V = (const bf16*)(F.ws + WS_V); const bf16* KR = (const bf16*)(F.ws + WS_KR);
    bf16* MIXED = (bf16*)(F.ws + WS_H); float* SSQA = (float*)(F.ws + WS_SSQA);
    const int tid = F.tid, lane = F.lane, r32 = lane & 31, hi = lane >> 5, wid = F.wave;
    const int t0 = b * SEQ, q0 = qb * 256 + wid * 32;
    bf16x8 qf[6];
    { const bf16* qp = Q + (size_t)(t0 + q0 + r32) * 768 + h * 96 + hi * 8;
#pragma unroll
      for (int s = 0; s < 6; ++s) qf[s] = *(const bf16x8*)(qp + 16 * s); }
    const int NT = 4 * qb + 4, ntw = 4 * qb + (wid >> 1) + 1;
    const int prow = tid >> 3, pch = tid & 7, rrow = tid >> 2, rch = tid & 3;
    const bf16* ksrc = Kn + (size_t)(t0 + prow) * 512 + h * 64 + pch * 8;
    const bf16* vsrc = V + (size_t)(t0 + prow) * 512 + h * 64 + pch * 8;
    const bf16* rsrc = KR + (size_t)(t0 + rrow) * 32 + rch * 8;
    const int kdst = prow * AT_KROW + pch * 16, rdst = rrow * AT_KROW + 128 + rch * 16, vdst = AT_KBUF + (pch >> 2) * 4096 + prow * 64 + (pch & 3) * 16;
    u32x4 kreg, vreg, rreg = (u32x4){0u, 0u, 0u, 0u};
    kreg = *(const u32x4*)ksrc; vreg = *(const u32x4*)vsrc; if (tid < 256) rreg = *(const u32x4*)rsrc;
    __syncthreads();
    *(LAS u32x4*)(F.lds + kdst) = kreg; *(LAS u32x4*)(F.lds + vdst) = vreg; if (tid < 256) *(LAS u32x4*)(F.lds + rdst) = rreg;
    __syncthreads();
    float mrun = -1e30f, lrun = 0.f; f32x16 o0, o1;
#pragma unroll
    for (int r = 0; r < 16; ++r) { o0[r] = 0.f; o1[r] = 0.f; }
    const int koff = r32 * AT_KROW + hi * 16;
    const int voff = AT_KBUF + ((lane >> 4) & 1) * 32 + (lane & 3) * 8 + (4 * hi + ((lane & 15) >> 2)) * 64;
    for (int t = 0; t < NT; ++t) {
        const bool more = (t + 1 < NT);
        if (more) { const size_t adv = (size_t)(t + 1) * 64; kreg = *(const u32x4*)(ksrc + adv * 512); vreg = *(const u32x4*)(vsrc + adv * 512); if (tid < 256) rreg = *(const u32x4*)(rsrc + adv * 32); }
        if (t < ntw) {
            const LAS unsigned char* base = F.lds + (t & 1) * AT_BUF;
            f32x16 p0, p1;
#pragma unroll
            for (int r = 0; r < 16; ++r) { p0[r] = 0.f; p1[r] = 0.f; }
#pragma unroll
            for (int s = 0; s < 6; ++s) { const bf16x8 a0 = *(const LAS bf16x8*)(base + koff + s * 32), a1 = *(const LAS bf16x8*)(base + koff + 32 * AT_KROW + s * 32);
                p0 = __builtin_amdgcn_mfma_f32_32x32x16_bf16(a0, qf[s], p0, 0, 0, 0); p1 = __builtin_amdgcn_mfma_f32_32x32x16_bf16(a1, qf[s], p1, 0, 0, 0); }
            float mx = fmaxf(p0[0], p1[0]);
#pragma unroll
            for (int r = 1; r < 16; ++r) mx = fmaxf(mx, fmaxf(p0[r], p1[r]));
            mx = fmaxf(mx, __shfl_xor(mx, 32));
            const float mnew = fmaxf(mrun, mx), alpha = __builtin_amdgcn_exp2f(mrun - mnew); mrun = mnew;
            float rs = 0.f;
#pragma unroll
            for (int r = 0; r < 16; ++r) { p0[r] = __builtin_amdgcn_exp2f(p0[r] - mnew); p1[r] = __builtin_amdgcn_exp2f(p1[r] - mnew); rs += p0[r] + p1[r]; }
            lrun = lrun * alpha + rs;
#pragma unroll
            for (int r = 0; r < 16; ++r) { o0[r] *= alpha; o1[r] *= alpha; }
            bf16x8 pf[4];
            { u32x4 w;
              w = (u32x4){cvt_pk_bf16(p0[0], p0[1]), cvt_pk_bf16(p0[2], p0[3]), cvt_pk_bf16(p0[4], p0[5]), cvt_pk_bf16(p0[6], p0[7])}; pf[0] = __builtin_bit_cast(bf16x8, w);
              w = (u32x4){cvt_pk_bf16(p0[8], p0[9]), cvt_pk_bf16(p0[10], p0[11]), cvt_pk_bf16(p0[12], p0[13]), cvt_pk_bf16(p0[14], p0[15])}; pf[1] = __builtin_bit_cast(bf16x8, w);
              w = (u32x4){cvt_pk_bf16(p1[0], p1[1]), cvt_pk_bf16(p1[2], p1[3]), cvt_pk_bf16(p1[4], p1[5]), cvt_pk_bf16(p1[6], p1[7])}; pf[2] = __builtin_bit_cast(bf16x8, w);
              w = (u32x4){cvt_pk_bf16(p1[8], p1[9]), cvt_pk_bf16(p1[10], p1[11]), cvt_pk_bf16(p1[12], p1[13]), cvt_pk_bf16(p1[14], p1[15])}; pf[3] = __builtin_bit_cast(bf16x8, w); }
#pragma unroll
            for (int ks = 0; ks < 4; ++ks) {
                const s16x4 l0 = vtr(base + voff + ks * 1024), h0 = vtr(base + voff + ks * 1024 + 512);
                const s16x4 l1 = vtr(base + voff + 4096 + ks * 1024), h1 = vtr(base + voff + 4096 + ks * 1024 + 512);
                const bf16x8 v0 = (bf16x8){l0[0], l0[1], l0[2], l0[3], h0[0], h0[1], h0[2], h0[3]}, v1 = (bf16x8){l1[0], l1[1], l1[2], l1[3], h1[0], h1[1], h1[2], h1[3]};
                o0 = __builtin_amdgcn_mfma_f32_32x32x16_bf16(v0, pf[ks], o0, 0, 0, 0); o1 = __builtin_amdgcn_mfma_f32_32x32x16_bf16(v1, pf[ks], o1, 0, 0, 0);
            }
        }
        if (more) { LAS unsigned char* nb = F.lds + ((t + 1) & 1) * AT_BUF;
            *(LAS u32x4*)(nb + kdst) = kreg; *(LAS u32x4*)(nb + vdst) = vreg; if (tid < 256) *(LAS u32x4*)(nb + rdst) = rreg; }
        __syncthreads();
    }
    const float ltot = lrun + __shfl_xor(lrun, 32), inv = 1.f / ltot;
    float ss = 0.f;
#pragma unroll
    for (int r = 0; r < 16; ++r) { o0[r] *= inv; o1[r] *= inv; ss += o0[r] * o0[r] + o1[r] * o1[r]; }
    ss += __shfl_xor(ss, 32);
    const int trow = t0 + q0 + r32;
    if (hi == 0) SSQA[(size_t)trow * 8 + h] = ss;
    bf16* op = MIXED + (size_t)trow * DM + h * 64 + 4 * hi;
#pragma unroll
    for (int g = 0; g < 4; ++g) {
        *(u32x2*)(op + 8 * g) = (u32x2){cvt_pk_bf16(o0[4 * g], o0[4 * g + 1]), cvt_pk_bf16(o0[4 * g + 2], o0[4 * g + 3])};
        *(u32x2*)(op + 32 + 8 * g) = (u32x2){cvt_pk_bf16(o1[4 * g], o1[4 * g + 1]), cvt_pk_bf16(o1[4 * g + 2], o1[4 * g + 3])};
    }
}
__device__ __forceinline__ void conv_block(Frame& F, const MKArgs& A, int blk) {
    const bf16* Z = (const bf16*)(F.ws + WS_Z); const bf16* BG = (const bf16*)(F.ws + WS_BG); bf16* MIXED = (bf16*)(F.ws + WS_H);
    const float* cw = INP(12); const float* cb = INP(13);
    const int ch = 8 * F.lane; float w0[8], w1[8], w2[8], bb[8];
#pragma unroll
    for (int j = 0; j < 8; ++j) { w0[j] = cw[ch + j]; w1[j] = cw[512 + ch + j]; w2[j] = cw[1024 + ch + j]; bb[j] = cb[ch + j]; }
    const int row0 = blk * 128 + F.wave * 16; const int s0 = row0 % SEQ;
    float zm2[8], zm1[8];
#define ldz(row, o) do { const u32x4 v_ = *(const u32x4*)(Z + (size_t)(row) * 512 + ch); \
        o[0] = bf2f(v_.x & 0xffff); o[1] = bf2f(v_.x >> 16); o[2] = bf2f(v_.y & 0xffff); o[3] = bf2f(v_.y >> 16); o[4] = bf2f(v_.z & 0xffff); o[5] = bf2f(v_.z >> 16); o[6] = bf2f(v_.w & 0xffff); o[7] = bf2f(v_.w >> 16); } while (0)
#pragma unroll
    for (int j = 0; j < 8; ++j) { zm2[j] = 0.f; zm1[j] = 0.f; }
    if (s0 >= 2) { ldz(row0 - 2, zm2); ldz(row0 - 1, zm1); }
    for (int i = 0; i < 16; ++i) { const int row = row0 + i; float zc[8], bgv[8], val[8]; ldz(row, zc);
        { const u32x4 v = *(const u32x4*)(BG + (size_t)row * 512 + ch);
          bgv[0] = bf2f(v.x & 0xffff); bgv[1] = bf2f(v.x >> 16); bgv[2] = bf2f(v.y & 0xffff); bgv[3] = bf2f(v.y >> 16); bgv[4] = bf2f(v.z & 0xffff); bgv[5] = bf2f(v.z >> 16); bgv[6] = bf2f(v.w & 0xffff); bgv[7] = bf2f(v.w >> 16); }
        float ss = 0.f;
#pragma unroll
        for (int j = 0; j < 8; ++j) { val[j] = bgv[j] * (w0[j] * zm2[j] + w1[j] * zm1[j] + w2[j] * zc[j] + bb[j]); ss += val[j] * val[j]; zm2[j] = zm1[j]; zm1[j] = zc[j]; }
        const float r = rsqrtf(wave_sum(ss) * (1.f / 512.f) + RMS_EPS);
        *(u32x4*)(MIXED + (size_t)row * DM + 512 + ch) = (u32x4){pk2(val[0] * r, val[1] * r), pk2(val[2] * r, val[3] * r), pk2(val[4] * r, val[5] * r), pk2(val[6] * r, val[7] * r)};
    }
}
__device__ __forceinline__ void phase4(Frame& F, const MKArgs& A) {
    for (int v = F.vcu; v < 256; v += F.G) {
        const int bh = v >> 1, s = v & 1;
        for (int i = 0; i < 4; ++i) { const int qb = (i == 0) ? s : (i == 1) ? 7 - s : (i == 2) ? 2 + s : 5 - s; attn_unit(F, A, bh >> 3, bh & 7, qb); }
    }
    for (int blk = F.bid; blk < T / 128; blk += F.G) conv_block(F, A, blk);
}

__device__ __forceinline__ void phase6(Frame& F, const MKArgs& A) {
    const float* x1 = A.xo; const float* g = INP(17); const float* mod = (const float*)(F.ws + WS_MOD);
    const float* wrg = INP(18); const float* brg = INP(19); const float* wre = INP(20); const float* bre = INP(21);
    bf16* H2 = (bf16*)(F.ws + WS_H); unsigned* cnt = (unsigned*)(F.ws + WS_CTL) + CW_CNT;
    int* ltok = (int*)(F.ws + WS_LTOK); float* lw = (float*)(F.ws + WS_LW); int* route = (int*)(F.ws + WS_ROUTE);
    LAS float* WR = (LAS float*)F.lds;
    LAS float* Gs = (LAS float*)(F.lds + 147456); LAS float* Ss = Gs + 1024;
    __syncthreads();
    for (int i = F.tid; i < 1024 * 4; i += NTHR) { const int k = i >> 2, e = i & 3; WR[e * 1024 + k] = wrg[i]; }
    for (int i = F.tid; i < 1024 * 32; i += NTHR) { const int k = i >> 5, e = i & 31; WR[(4 + e) * 1024 + k] = wre[i]; }
    for (int blk = F.bid; blk < T / 128; blk += F.G) {
        const int b = (blk * 128) / SEQ;
        __syncthreads();
        for (int k = F.tid; k < 1024; k += NTHR) { Gs[k] = g[k] * (1.f + mod[b * 6144 + 4096 + k]); Ss[k] = mod[b * 6144 + 3072 + k]; }
        __syncthreads();
        for (int rr = F.wave; rr < 128; rr += NWAVES) {
            const int row = blk * 128 + rr;
            const f32x4* xr = (const f32x4*)(x1 + (size_t)row * DM) + F.lane;
            f32x4 v[4]; float s = 0.f;
#pragma unroll
            for (int j = 0; j < 4; ++j) { v[j] = xr[64 * j]; s += (v[j].x * v[j].x + v[j].y * v[j].y) + (v[j].z * v[j].z + v[j].w * v[j].w); }
            const float r = rsqrtf(wave_sum(s) * (1.f / DM) + RMS_EPS);
            unsigned long long* o8 = (unsigned long long*)(H2 + (size_t)row * DM) + F.lane;
#pragma unroll
            for (int j = 0; j < 4; ++j) { const f32x4 gg = *(const LAS f32x4*)(Gs + 4 * F.lane + 256 * j), ss = *(const LAS f32x4*)(Ss + 4 * F.lane + 256 * j);
                v[j] = v[j] * r * gg + ss;
                o8[64 * j] = (unsigned long long)pk2(v[j].x, v[j].y) | ((unsigned long long)pk2(v[j].z, v[j].w) << 32); }
            float gl[4];
#pragma unroll
            for (int e = 0; e < 4; ++e) { float a = 0.f;
#pragma unroll
                for (int j = 0; j < 4; ++j) { const f32x4 w = *(const LAS f32x4*)(WR + e * 1024 + 4 * F.lane + 256 * j); a += (v[j].x * w.x + v[j].y * w.y) + (v[j].z * w.z + v[j].w * w.w); }
                gl[e] = wave_sum(a) + brg[e]; }
            int gi = 0; float gm = gl[0];
#pragma unroll
            for (int e = 1; e < 4; ++e) if (gl[e] > gm) { gm = gl[e]; gi = e; }
            gi = __builtin_amdgcn_readfirstlane(gi);
            float se = 0.f;
#pragma unroll
            for (int e = 0; e < 4; ++e) se += __expf(gl[e] - gm);
            const float pg = 1.f / se;
            float el[8];
            const LAS float* WE = WR + (4 + gi * 8) * 1024;
#pragma unroll
            for (int e = 0; e < 8; ++e) { float a = 0.f;
#pragma unroll
                for (int j = 0; j < 4; ++j) { const f32x4 w = *(const LAS f32x4*)(WE + e * 1024 + 4 * F.lane + 256 * j); a += (v[j].x * w.x + v[j].y * w.y) + (v[j].z * w.z + v[j].w * w.w); }
                el[e] = wave_sum(a) + bre[gi * 8 + e]; }
            int i0 = 0; float v0 = el[0];
#pragma unroll
            for (int e = 1; e < 8; ++e) if (el[e] > v0) { v0 = el[e]; i0 = e; }
            int i1 = -1; float v1 = -3.0e38f;
#pragma unroll
            for (int e = 0; e < 8; ++e) if (e != i0 && el[e] > v1) { v1 = el[e]; i1 = e; }
            const float e1 = __expf(v1 - v0); const float w0 = pg / (1.f + e1), w1 = pg * e1 / (1.f + e1);
            if (F.lane == 0) {
                const int ex0 = gi * 8 + i0, ex1 = gi * 8 + i1;
                const unsigned s0 = atomicAdd(&cnt[ex0], 1u), s1 = atomicAdd(&cnt[ex1], 1u);
                ltok[(size_t)ex0 * LIST_CAP + s0] = row * 2; lw[(size_t)ex0 * LIST_CAP + s0] = w0;
                ltok[(size_t)ex1 * LIST_CAP + s1] = row * 2 + 1; lw[(size_t)ex1 * LIST_CAP + s1] = w1;
                route[row * 4] = ex0; route[row * 4 + 1] = ex1; ((float*)route)[row * 4 + 2] = w0; ((float*)route)[row * 4 + 3] = w1;
            }
        }
    }
}

__device__ __forceinline__ void phase8(Frame& F, const MKArgs& A) {
    float* xo = A.xo; const float* fg = INP(25); const float* mod = (const float*)(F.ws + WS_MOD); const bf16* Y = (const bf16*)(F.ws + WS_Y);
    for (int blk = F.bid; blk < T / 128; blk += F.G) {
        const int b = (blk * 128) / SEQ; const float* g2 = mod + b * 6144 + 5120;
        f32x4 gv[4], fv[4];
#pragma unroll
        for (int j = 0; j < 4; ++j) { gv[j] = *(const f32x4*)(g2 + 4 * F.lane + 256 * j); fv[j] = *(const f32x4*)(fg + 4 * F.lane + 256 * j); }
        for (int rr = F.wave; rr < 128; rr += NWAVES) {
            const int row = blk * 128 + rr;
            f32x4* xr = (f32x4*)(xo + (size_t)row * DM) + F.lane;
            const u32x2* y0 = (const u32x2*)(Y + (size_t)row * DM) + F.lane; const u32x2* y1 = (const u32x2*)(Y + ((size_t)T + row) * DM) + F.lane;
            f32x4 v[4]; float s = 0.f;
#pragma unroll
            for (int j = 0; j < 4; ++j) { const u32x2 a = y0[64 * j], c = y1[64 * j];
                f32x4 yy; yy.x = bf2f(a.x & 0xffff) + bf2f(c.x & 0xffff); yy.y = bf2f(a.x >> 16) + bf2f(c.x >> 16); yy.z = bf2f(a.y & 0xffff) + bf2f(c.y & 0xffff); yy.w = bf2f(a.y >> 16) + bf2f(c.y >> 16);
                v[j] = xr[64 * j] + gv[j] * yy; s += (v[j].x * v[j].x + v[j].y * v[j].y) + (v[j].z * v[j].z + v[j].w * v[j].w); }
            const float r = rsqrtf(wave_sum(s) * (1.f / DM) + RMS_EPS);
#pragma unroll
            for (int j = 0; j < 4; ++j) xr[64 * j] = v[j] * r * fv[j];
        }
    }
}

constexpr int N_PHASES = 10;
__global__ void __launch_bounds__(NTHR, 2) mk_fwd(MKArgs args) {
    extern __shared__ __attribute__((aligned(16))) unsigned char lds_raw[];
    Frame F; F.lds = (LAS unsigned char*)lds_raw; F.tid = threadIdx.x; F.lane = F.tid & 63; F.wave = __builtin_amdgcn_readfirstlane(F.tid >> 6);
    F.bid = blockIdx.x; F.G = gridDim.x; F.vcu = (F.G % 8 == 0) ? (F.bid % 8) * (F.G / 8) + F.bid / 8 : F.bid; F.ws = args.ws;
    volatile LAS unsigned* MISC = (volatile LAS unsigned*)(F.lds + MISC_OFF);
    for (int u = F.tid; u < 128; u += NTHR) MISC[u] = 0u;
    __syncthreads();
    const int lo = args.ph_lo, hi = args.ph_hi;
    XcdBarrier bar; bar.bar = (unsigned*)(F.ws + WS_CTL) + CW_BAR; bar.x = 0; bar.st = nullptr;
    if (hi - lo > 1) bar = xcd_barrier_post((unsigned*)(F.ws + WS_CTL) + CW_BAR, MISC + 8);
#ifndef PH_MASK
#define PH_MASK 0xFFFF
#endif
#define IN(k) (((PH_MASK >> (k)) & 1) && lo <= (k) && (k) < hi)
#define SEAM(k) do { if (IN(k) && IN((k) + 1)) xcd_barrier(bar); } while (0)
    if (IN(0)) { phase0(F, args); } SEAM(0);
    if (IN(1)) { phase1(F, args); } SEAM(1);
    if (IN(2)) {
        pg8::Gemm g{(const bf16*)(F.ws + WS_H), (const bf16*)(F.ws + WS_WIN), 1024}; pg8::StaticOrder S; S.init(T, 2048, F.G, F.bid);
        EpiP2 E{(bf16*)(F.ws + WS_QC), (bf16*)(F.ws + WS_KVX), (bf16*)(F.ws + WS_Z), (bf16*)(F.ws + WS_BG), (bf16*)(F.ws + WS_KR), (float*)(F.ws + WS_SSQQ), (float*)(F.ws + WS_SSQKV),
                (const float*)(F.ws + WS_ROPE), (const float*)(F.ws + WS_ROPE) + (size_t)T * 16};
        pg8::gemm_phase<EpiP2, pg8::StaticOrder, true>(F.lds, g, S, E);
    } SEAM(2);
    if (IN(3)) {
        { pg8::Gemm g{(const bf16*)(F.ws + WS_QC), (const bf16*)(F.ws + WS_WUQ), 256}; pg8::StaticOrder S; S.init(T, 768, F.G, F.bid);
          EpiQ E{(bf16*)(F.ws + WS_Q), (const float*)(F.ws + WS_SSQQ), (const float*)(F.ws + WS_ROPE), (const float*)(F.ws + WS_ROPE) + (size_t)T * 16};
          pg8::gemm_phase<EpiQ, pg8::StaticOrder, true>(F.lds, g, S, E); }
        { pg8::Gemm g{(const bf16*)(F.ws + WS_KVX), (const bf16*)(F.ws + WS_WUKV), 256}; pg8::StaticOrder S; S.init(T, 1024, F.G, F.G - 1 - F.bid);
          EpiKV E{(bf16*)(F.ws + WS_K), (bf16*)(F.ws + WS_V), (const float*)(F.ws + WS_SSQKV)};
          pg8::gemm_phase<EpiKV, pg8::StaticOrder, true>(F.lds, g, S, E); }
    } SEAM(3);
    if (IN(4)) { phase4(F, args); } SEAM(4);
    if (IN(5)) {
        pg8::Gemm g{(const bf16*)(F.ws + WS_H), (const bf16*)(F.ws + WS_WOUT), 1024}; pg8::StaticOrder S; S.init(T, 1024, F.G, F.bid);
        EpiOut E{args.in[0], (const float*)(F.ws + WS_MOD), args.xo, (const float*)(F.ws + WS_SSQA)};
        pg8::gemm_phase<EpiOut, pg8::StaticOrder, true>(F.lds, g, S, E);
    } SEAM(5);
    if (IN(6)) { phase6(F, args); } SEAM(6);
    if (IN(7) || IN(8)) {
        const unsigned* cnt = (const unsigned*)(F.ws + WS_CTL) + CW_CNT;
        __syncthreads();
        if (F.tid == 0) { int acc = 0; for (int e = 0; e < 32; ++e) { ((volatile LAS int*)MISC)[16 + e] = acc; acc += (int)((__hip_atomic_load(cnt + e, __ATOMIC_RELAXED, __HIP_MEMORY_SCOPE_AGENT) + 255u) >> 8); } ((volatile LAS int*)MISC)[16 + 32] = acc; }
        __syncthreads();
    }
    if (IN(7)) {
        const unsigned* cnt = (const unsigned*)(F.ws + WS_CTL) + CW_CNT;
        pg8::Gemm g{(const bf16*)(F.ws + WS_H), (const bf16*)(F.ws + WS_WGU), 1024};
        MoeOrder<true> S{(volatile LAS int*)MISC + 16, 2, F.G, F.bid, cnt, (const int*)(F.ws + WS_LTOK)};
        EpiAct E{(bf16*)(F.ws + WS_ACT)};
        pg8::gemm_phase<EpiAct, MoeOrder<true>, true>(F.lds, g, S, E);
    } SEAM(7);
    if (IN(8)) {
        const unsigned* cnt = (const unsigned*)(F.ws + WS_CTL) + CW_CNT;
        pg8::Gemm g{(const bf16*)(F.ws + WS_ACT), (const bf16*)(F.ws + WS_WD), 256};
        MoeOrder<false> S{(volatile LAS int*)MISC + 16, 4, F.G, F.bid, cnt, (const int*)(F.ws + WS_LTOK)};
        EpiDown E{(bf16*)(F.ws + WS_Y), (const int*)(F.ws + WS_LTOK), (const float*)(F.ws + WS_LW), cnt};
        pg8::gemm_phase<EpiDown, MoeOrder<false>, true>(F.lds, g, S, E);
    } SEAM(8);
    if (IN(9)) { phase8(F, args); }
#undef IN
#undef SEAM
}
#if MK_DEBUG
namespace ck {
__device__ __forceinline__ unsigned hsh(unsigned x) { x ^= x >> 16; x *= 0x7feb352du; x ^= x >> 15; x *= 0x846ca68bu; x ^= x >> 16; return x; }
__device__ __forceinline__ void chk(unsigned* err, int stage, float got, float ref, float atol, float rtol) { if (!(fabsf(got - ref) <= atol + rtol * fabsf(ref))) atomicAdd(&err[stage], 1u); }
__device__ __forceinline__ float bfr(float f) { return bf2f((unsigned short)f2bf(f)); }
__device__ __forceinline__ float dotbf(const bf16* a, const bf16* b, int n) { float s = 0.f; for (int i = 0; i < n; ++i) s += bf2f(a[i]) * bf2f(b[i]); return s; }
#define ERRP ((unsigned*)(ws + WS_CTL) + CW_ERR)
#define SID (blockIdx.x * blockDim.x + threadIdx.x)

__global__ void c0(MKArgs A) { unsigned char* ws = A.ws; unsigned* err = ERRP; const unsigned s = hsh(SID * 7 + 1);
    const float* mod = (const float*)(ws + WS_MOD);
    { const int b = s & 15, n = (s >> 4) % 6144; float r = 0.f; for (int k = 0; k < 1024; ++k) { float cv = A.in[1][b * 1024 + k]; r += cv / (1.f + expf(-cv)) * A.in[3][(size_t)k * 6144 + n]; } r += A.in[4][n];
      chk(err, 0, mod[b * 6144 + n], r, 2e-3f, 2e-3f); }
    { const int n = (s >> 3) & 2047, k = (s >> 14) & 1023; const int sc = win_src(n & ~31); const float r = sc >= 0 ? bfr(A.in[6][(size_t)k * 1952 + sc + (n & 31)]) : 0.f;
      chk(err, 0, bf2f(((const bf16*)(ws + WS_WIN))[(size_t)n * 1024 + k]), r, 1e-6f, 1e-2f); }
    { const int n = (s >> 5) % 768, k = (s >> 15) & 255; const float r = A.in[9][(size_t)k * 768 + n] * A.in[7][k] * QSCALE;
      chk(err, 0, bf2f(((const bf16*)(ws + WS_WUQ))[(size_t)n * 256 + k]), r, 1e-6f, 1e-2f); }
    { const int n = (s >> 6) & 1023, k = (s >> 16) & 255; const float r = k < 128 ? (n < 512 ? A.in[10][(size_t)k * 512 + n] : A.in[11][(size_t)k * 512 + n - 512]) * A.in[8][k] : 0.f;
      chk(err, 0, bf2f(((const bf16*)(ws + WS_WUKV))[(size_t)n * 256 + k]), r, 1e-6f, 1e-2f); }
    { const int n = (s >> 7) & 1023, k = (s >> 17) & 1023; const float r = A.in[16][(size_t)k * 1024 + n] * (k < 512 ? A.in[14][k] : A.in[15][k - 512]);
      chk(err, 0, bf2f(((const bf16*)(ws + WS_WOUT))[(size_t)n * 1024 + k]), r, 1e-6f, 1e-2f); }
    { const int e = s & 31, n = (s >> 5) & 511, k = (s >> 14) & 1023; const int p = n >> 8, j = n & 255;
      const float r = j < 128 ? A.in[22][((size_t)e * 1024 + k) * 256 + 128 * p + j] : A.in[23][((size_t)e * 1024 + k) * 256 + 128 * p + j - 128];
      chk(err, 0, bf2f(((const bf16*)(ws + WS_WGU))[((size_t)e * 512 + n) * 1024 + k]), r, 1e-6f, 1e-2f); }
    { const int e = (s >> 2) & 31, n = (s >> 7) & 1023, k = (s >> 17) & 255; const float r = A.in[24][((size_t)e * 256 + k) * 1024 + n];
      chk(err, 0, bf2f(((const bf16*)(ws + WS_WD))[((size_t)e * 1024 + n) * 256 + k]), r, 1e-6f, 1e-2f); }
    { const int t = (s >> 4) & 32767, i = s & 15; const float ang = (float)((const int*)A.in[2])[t] * (1.0f / powf(10000.0f, (float)(2 * i) / 32.0f));
      const float* cs = (const float*)(ws + WS_ROPE); chk(err, 0, cs[t * 16 + i], cosf(ang), 1e-4f, 0.f); chk(err, 0, cs[(size_t)T * 16 + t * 16 + i], sinf(ang), 1e-4f, 0.f); }
}
__device__ __forceinline__ float row_rms(const float* x) { float s = 0.f; for (int k = 0; k < 1024; ++k) s += x[k] * x[k]; return rsqrtf(s / 1024.f + RMS_EPS); }
__global__ void c1(MKArgs A) { unsigned char* ws = A.ws; unsigned* err = ERRP; const unsigned s = hsh(SID * 5 + 3);
    const int t = s & 32767, k = (s >> 15) & 1023, b = t / SEQ; const float* mod = (const float*)(ws + WS_MOD);
    const float r = row_rms(A.in[0] + (size_t)t * 1024);
    const float ref = A.in[0][(size_t)t * 1024 + k] * r * A.in[5][k] * (1.f + mod[b * 6144 + 1024 + k]) + mod[b * 6144 + k];
    chk(err, 1, bf2f(((const bf16*)(ws + WS_H))[(size_t)t * 1024 + k]), ref, 2e-3f, 1e-2f);
}
__global__ void c2(MKArgs A) { unsigned char* ws = A.ws; unsigned* err = ERRP; const unsigned s = hsh(SID * 3 + 11);
    const bf16* H = (const bf16*)(ws + WS_H); const bf16* W = (const bf16*)(ws + WS_WIN);
    const int t = s & 32767; const bf16* h = H + (size_t)t * 1024;
    const float* cs = (const float*)(ws + WS_ROPE); const float* sn = cs + (size_t)T * 16;
    const int sel = (s >> 15) % 6; const int j = (s >> 18);
    if (sel == 0) { const int c = j & 255; chk(err, 2, bf2f(((const bf16*)(ws + WS_QC))[(size_t)t * 256 + c]), dotbf(h, W + (size_t)c * 1024, 1024), 2e-2f, 2e-2f); }
    else if (sel == 1) { const int c = j & 255; const float r = c < 160 ? dotbf(h, W + (size_t)(256 + c) * 1024, 1024) : 0.f; chk(err, 2, bf2f(((const bf16*)(ws + WS_KVX))[(size_t)t * 256 + c]), r, 2e-2f, 2e-2f); }
    else if (sel == 2) { const int i = j & 15; const float x1 = dotbf(h, W + (size_t)(384 + i) * 1024, 1024), x2 = dotbf(h, W + (size_t)(400 + i) * 1024, 1024); const float c = cs[t * 16 + i], sv = sn[t * 16 + i];
        chk(err, 2, bf2f(((const bf16*)(ws + WS_KR))[(size_t)t * 32 + i]), x1 * c - x2 * sv, 3e-2f, 2e-2f); chk(err, 2, bf2f(((const bf16*)(ws + WS_KR))[(size_t)t * 32 + 16 + i]), x2 * c + x1 * sv, 3e-2f, 2e-2f); }
    else if (sel == 3) { const int ch = j & 511, p = ch >> 7, jj = ch & 127; const float u = dotbf(h, W + (size_t)(512 + 256 * p + jj) * 1024, 1024), c = dotbf(h, W + (size_t)(512 + 256 * p + 128 + jj) * 1024, 1024);
        chk(err, 2, bf2f(((const bf16*)(ws + WS_Z))[(size_t)t * 512 + ch]), u * c, 3e-2f, 3e-2f); }
    else if (sel == 4) { const int ch = j & 511; chk(err, 2, bf2f(((const bf16*)(ws + WS_BG))[(size_t)t * 512 + ch]), dotbf(h, W + (size_t)(1536 + ch) * 1024, 1024), 2e-2f, 2e-2f); }
    else { const bf16* qc = (const bf16*)(ws + WS_QC) + (size_t)t * 256; const bf16* kv = (const bf16*)(ws + WS_KVX) + (size_t)t * 256; float a = 0.f, b = 0.f;
        for (int i = 0; i < 256; ++i) a += bf2f(qc[i]) * bf2f(qc[i]); for (int i = 0; i < 128; ++i) b += bf2f(kv[i]) * bf2f(kv[i]);
        const float* sq = (const float*)(ws + WS_SSQQ) + (size_t)t * 4; const float* sk = (const float*)(ws + WS_SSQKV) + (size_t)t * 4;
        chk(err, 2, sq[0] + sq[1] + sq[2] + sq[3], a, 1e-2f, 2e-2f); chk(err, 2, sk[0] + sk[1] + sk[2] + sk[3], b, 1e-2f, 2e-2f); }
}
__global__ void c3(MKArgs A) { unsigned char* ws = A.ws; unsigned* err = ERRP; const unsigned s = hsh(SID * 13 + 5);
    const int t = s & 32767; const float* cs = (const float*)(ws + WS_ROPE); const float* sn = cs + (size_t)T * 16;
    const bf16* qc = (const bf16*)(ws + WS_QC) + (size_t)t * 256; const bf16* kv = (const bf16*)(ws + WS_KVX) + (size_t)t * 256;
    if ((s >> 15) & 1) { float a = 0.f; for (int i = 0; i < 256; ++i) a += bf2f(qc[i]) * bf2f(qc[i]); const float rq = rsqrtf(a / 256.f + RMS_EPS);
        const int col = (s >> 16) % 768, d = col % 96; const bf16* W = (const bf16*)(ws + WS_WUQ); float ref;
        if (d < 64) ref = dotbf(qc, W + (size_t)col * 256, 256) * rq;
        else { const int i = (d - 64) & 15, c1_ = col - d + 64 + i, c2_ = c1_ + 16; const float x1 = dotbf(qc, W + (size_t)c1_ * 256, 256) * rq, x2 = dotbf(qc, W + (size_t)c2_ * 256, 256) * rq;
            ref = (d - 64) < 16 ? x1 * cs[t * 16 + i] - x2 * sn[t * 16 + i] : x2 * cs[t * 16 + i] + x1 * sn[t * 16 + i]; }
        chk(err, 3, bf2f(((const bf16*)(ws + WS_Q))[(size_t)t * 768 + col]), ref, 2e-2f, 2e-2f);
    } else { float a = 0.f; for (int i = 0; i < 128; ++i) a += bf2f(kv[i]) * bf2f(kv[i]); const float rk = rsqrtf(a / 128.f + RMS_EPS);
        const int col = (s >> 16) & 1023; const float ref = dotbf(kv, (const bf16*)(ws + WS_WUKV) + (size_t)col * 256, 256) * rk;
        const float got = col < 512 ? bf2f(((const bf16*)(ws + WS_K))[(size_t)t * 512 + col]) : bf2f(((const bf16*)(ws + WS_V))[(size_t)t * 512 + col - 512]);
        chk(err, 3, got, ref, 2e-2f, 2e-2f); }
}
__global__ void c4(MKArgs A) { unsigned char* ws = A.ws; unsigned* err = ERRP; const unsigned s = hsh(SID * 17 + 9);
    const bf16* M = (const bf16*)(ws + WS_H);
    const int t = s & 32767, b = t / SEQ, qi = t % SEQ;
    if (SID < 8192) { const int h = (s >> 15) & 7, d = (s >> 18) & 63; const int nk = (qi / 64 + 1) * 64;
        const bf16* q = (const bf16*)(ws + WS_Q) + (size_t)t * 768 + h * 96; float mx = -1e30f, l = 0.f, o = 0.f, ssq = 0.f;
        for (int j = 0; j < nk; ++j) { const size_t tj = (size_t)b * SEQ + j; float sc = dotbf(q, (const bf16*)(ws + WS_K) + tj * 512 + h * 64, 64) + dotbf(q + 64, (const bf16*)(ws + WS_KR) + tj * 32, 32);
            const float mn = fmaxf(mx, sc), al = exp2f(mx - mn), p = exp2f(sc - mn); l = l * al + p; o = o * al + p * bf2f(((const bf16*)(ws + WS_V))[tj * 512 + h * 64 + d]); mx = mn; }
        chk(err, 4, bf2f(M[(size_t)t * 1024 + h * 64 + d]), o / l, 1e-2f, 3e-2f);
        for (int dd = 0; dd < 64; ++dd) { const float v = bf2f(M[(size_t)t * 1024 + h * 64 + dd]); ssq += v * v; }
        chk(err, 4, ((const float*)(ws + WS_SSQA))[(size_t)t * 8 + h], ssq, 1e-3f, 3e-2f);
    } else if (SID < 8192 + 4096) { const bf16* Z = (const bf16*)(ws + WS_Z); const bf16* BG = (const bf16*)(ws + WS_BG); const int chs = (s >> 15) & 511; float ss = 0.f, mine = 0.f;
        for (int ch = 0; ch < 512; ++ch) { float zc = A.in[13][ch];
            for (int w = 0; w < 3; ++w) { const int ts = qi + w - 2; if (ts >= 0) zc += bf2f(Z[(size_t)(t + w - 2) * 512 + ch]) * A.in[12][w * 512 + ch]; }
            const float v = bf2f(BG[(size_t)t * 512 + ch]) * zc; ss += v * v; if (ch == chs) mine = v; }
        chk(err, 4, bf2f(M[(size_t)t * 1024 + 512 + chs]), mine * rsqrtf(ss / 512.f + RMS_EPS), 1e-2f, 2e-2f); }
}
__global__ void c5(MKArgs A) { unsigned char* ws = A.ws; unsigned* err = ERRP; const unsigned s = hsh(SID * 19 + 2);
    const int t = s & 32767, n = (s >> 15) & 1023, b = t / SEQ; const bf16* M = (const bf16*)(ws + WS_H) + (size_t)t * 1024; const bf16* W = (const bf16*)(ws + WS_WOUT) + (size_t)n * 1024;
    const float* sa = (const float*)(ws + WS_SSQA) + (size_t)t * 8; float a = 0.f; for (int i = 0; i < 8; ++i) a += sa[i]; const float ra = rsqrtf(a / 512.f + RMS_EPS);
    const float acc = ra * dotbf(M, W, 512) + dotbf(M + 512, W + 512, 512); const float* mod = (const float*)(ws + WS_MOD);
    chk(err, 5, A.xo[(size_t)t * 1024 + n], A.in[0][(size_t)t * 1024 + n] + mod[b * 6144 + 2048 + n] * acc, 1e-2f, 1e-2f);
}
__global__ void c6(MKArgs A) { unsigned char* ws = A.ws; unsigned* err = ERRP; const unsigned s = hsh(SID * 23 + 7);
    const int t = s & 32767, b = t / SEQ; const float* mod = (const float*)(ws + WS_MOD); const float* x1 = A.xo + (size_t)t * 1024; const float r = row_rms(x1);
    { const int k = (s >> 15) & 1023; const float ref = x1[k] * r * A.in[17][k] * (1.f + mod[b * 6144 + 4096 + k]) + mod[b * 6144 + 3072 + k];
      chk(err, 6, bf2f(((const bf16*)(ws + WS_H))[(size_t)t * 1024 + k]), ref, 2e-3f, 1e-2f); }
    if (SID < 4096) { float gl[4] = {0, 0, 0, 0}, el[32]; for (int e = 0; e < 32; ++e) el[e] = 0.f;
        for (int k = 0; k < 1024; ++k) { const float hv = x1[k] * r * A.in[17][k] * (1.f + mod[b * 6144 + 4096 + k]) + mod[b * 6144 + 3072 + k];
            for (int e = 0; e < 4; ++e) gl[e] += hv * A.in[18][k * 4 + e]; for (int e = 0; e < 32; ++e) el[e] += hv * A.in[20][k * 32 + e]; }
        for (int e = 0; e < 4; ++e) gl[e] += A.in[19][e]; for (int e = 0; e < 32; ++e) el[e] += A.in[21][e];
        int gi = 0; for (int e = 1; e < 4; ++e) if (gl[e] > gl[gi]) gi = e; float g2 = -1e30f; for (int e = 0; e < 4; ++e) if (e != gi) g2 = fmaxf(g2, gl[e]);
        float se = 0.f; for (int e = 0; e < 4; ++e) se += expf(gl[e] - gl[gi]);
        int i0 = 0; for (int e = 1; e < 8; ++e) if (el[gi * 8 + e] > el[gi * 8 + i0]) i0 = e; int i1 = -1; for (int e = 0; e < 8; ++e) if (e != i0 && (i1 < 0 || el[gi * 8 + e] > el[gi * 8 + i1])) i1 = e;
        float v2 = -1e30f; for (int e = 0; e < 8; ++e) if (e != i0 && e != i1) v2 = fmaxf(v2, el[gi * 8 + e]);
        const float v0 = el[gi * 8 + i0], v1 = el[gi * 8 + i1];
        if (gl[gi] - g2 > 1e-3f && v0 - v1 > 1e-3f && v1 - v2 > 1e-3f) { const int* rt = (const int*)(ws + WS_ROUTE) + t * 4; const float e1 = expf(v1 - v0), pg = 1.f / se;
            if (rt[0] != gi * 8 + i0 || rt[1] != gi * 8 + i1) atomicAdd(&err[6], 1u);
            chk(err, 6, ((const float*)rt)[2], pg / (1.f + e1), 1e-3f, 1e-2f); chk(err, 6, ((const float*)rt)[3], pg * e1 / (1.f + e1), 1e-3f, 1e-2f); } }
    { const unsigned* cnt = (const unsigned*)(ws + WS_CTL) + CW_CNT; if (SID == 0) { unsigned tot = 0; for (int e = 0; e < 32; ++e) tot += cnt[e]; if (tot != 65536u) atomicAdd(&err[6], 1u); }
      const int e = (s >> 3) & 31; const unsigned slot = (s >> 8) % (cnt[e] ? cnt[e] : 1u); if (cnt[e]) { const int tk = ((const int*)(ws + WS_LTOK))[(size_t)e * LIST_CAP + slot];
        const int* rt = (const int*)(ws + WS_ROUTE) + (tk >> 1) * 4; if ((tk >> 1) < 0 || (tk >> 1) >= T || rt[tk & 1] != e) atomicAdd(&err[6], 1u);
        else chk(err, 6, ((const float*)(ws + WS_LW))[(size_t)e * LIST_CAP + slot], ((const float*)rt)[2 + (tk & 1)], 0.f, 0.f); } }
}
__global__ void c7(MKArgs A) { unsigned char* ws = A.ws; unsigned* err = ERRP; const unsigned s = hsh(SID * 29 + 13);
    const unsigned* cnt = (const unsigned*)(ws + WS_CTL) + CW_CNT; const int e = s & 31; if (!cnt[e]) return; const unsigned slot = (s >> 5) % cnt[e];
    int pb = 0; for (int i = 0; i < e; ++i) pb += (cnt[i] + 255) >> 8;
    const int tk = ((const int*)(ws + WS_LTOK))[(size_t)e * LIST_CAP + slot]; const bf16* h2 = (const bf16*)(ws + WS_H) + (size_t)(tk >> 1) * 1024;
    const int j = (s >> 20) & 255, p = j >> 7, jj = j & 127; const bf16* W = (const bf16*)(ws + WS_WGU) + ((size_t)e * 512 + 256 * p + jj) * 1024;
    const float g = dotbf(h2, W, 1024), u = dotbf(h2, W + 128 * 1024, 1024);
    chk(err, 7, bf2f(((const bf16*)(ws + WS_ACT))[((size_t)pb * 256 + slot) * 256 + j]), g / (1.f + expf(-g)) * u, 2e-2f, 3e-2f);
}
__global__ void c8(MKArgs A) { unsigned char* ws = A.ws; unsigned* err = ERRP; const unsigned s = hsh(SID * 31 + 17);
    const unsigned* cnt = (const unsigned*)(ws + WS_CTL) + CW_CNT; const int e = s & 31; if (!cnt[e]) return; const unsigned slot = (s >> 5) % cnt[e];
    int pb = 0; for (int i = 0; i < e; ++i) pb += (cnt[i] + 255) >> 8;
    const int tk = ((const int*)(ws + WS_LTOK))[(size_t)e * LIST_CAP + slot]; const float w = ((const float*)(ws + WS_LW))[(size_t)e * LIST_CAP + slot];
    const int n = (s >> 20) & 1023; const float ref = w * dotbf((const bf16*)(ws + WS_ACT) + ((size_t)pb * 256 + slot) * 256, (const bf16*)(ws + WS_WD) + ((size_t)e * 1024 + n) * 256, 256);
    chk(err, 8, bf2f(((const bf16*)(ws + WS_Y))[((size_t)(tk & 1) * T + (tk >> 1)) * 1024 + n]), ref, 5e-3f, 3e-2f);
}
__global__ void c9(MKArgs A, const float* gold, float* acc2) { float d = 0.f, r = 0.f;
    for (size_t i = SID; i < (size_t)T * 1024; i += (size_t)gridDim.x * blockDim.x) { const float a = A.xo[i], b = gold[i]; d += (a - b) * (a - b); r += b * b; if (!(fabsf(a) < 1e30f)) d += 1e30f; }
    d = wave_sum(d); r = wave_sum(r); if ((threadIdx.x & 63) == 0) { atomicAdd(&acc2[0], d); atomicAdd(&acc2[1], r); }
}
__global__ void report(MKArgs A, float* gold, const float* acc2, int use_mega) { unsigned char* ws = A.ws; const unsigned* err = ERRP;
    int code = 0; for (int i = 0; i < 9; ++i) if (err[i] != 0 && code == 0) code = i + 1;
    if (code == 0 && !(acc2[0] <= 3e-5f * acc2[1])) code = 10;
    const float f = 1.f + 0.03f * code;
    for (size_t i = SID; i < (size_t)T * 1024; i += (size_t)gridDim.x * blockDim.x) gold[i] = (use_mega && code == 0 ? A.xo[i] : gold[i]) * f;
}
}
#endif
extern "C" void kernel_launch(void* const* d_in, const int* in_sizes, int n_in, void* d_out, int out_size, void* d_ws, size_t ws_size, hipStream_t stream) {
    static int grid = 0;
    if (grid == 0) {
        int dev = 0, cus = 0, per_cu = 0;
        if (n_in != 26 || out_size != T * DM || ws_size < 496 * MiB) { fprintf(stderr, "kernel_launch: unexpected problem (n_in %d out %d ws %zu)\n", n_in, out_size, ws_size); grid = -1; return; }
        if (hipGetDevice(&dev) != hipSuccess || hipDeviceGetAttribute(&cus, hipDeviceAttributeMultiprocessorCount, dev) != hipSuccess) { grid = -1; return; }
        if (hipFuncSetAttribute((const void*)mk_fwd, hipFuncAttributeMaxDynamicSharedMemorySize, LDS_BYTES) != hipSuccess) { fprintf(stderr, "kernel_launch: hipFuncSetAttribute failed\n"); grid = -1; return; }
        if (hipOccupancyMaxActiveBlocksPerMultiprocessor(&per_cu, (const void*)mk_fwd, NTHR, LDS_BYTES) != hipSuccess || per_cu < 1) { fprintf(stderr, "kernel_launch: occupancy query says %d\n", per_cu); }
        (void)hipGetLastError();
        grid = cus;
    }
    if (grid < 0) return;
    MKArgs a{};
    for (int i = 0; i < 26; ++i) a.in[i] = (const float*)d_in[i];
    a.ws = (unsigned char*)d_ws;
#if MK_DEBUG
    nv::run(d_in, (float*)d_out, (char*)d_ws, stream);
    (void)hipMemsetAsync(d_ws, 0, ZERO_BYTES, stream);
    a.xo = (float*)((char*)d_ws + WS_X1DBG);
    for (int p = 0; p < N_PHASES; ++p) {
        a.ph_lo = p; a.ph_hi = p + 1;
        hipLaunchKernelGGL(mk_fwd, dim3(grid), dim3(NTHR), LDS_BYTES, stream, a);
        switch (p) {
            case 0: hipLaunchKernelGGL(ck::c0, dim3(64), dim3(256), 0, stream, a); break;
            case 1: hipLaunchKernelGGL(ck::c1, dim3(64), dim3(256), 0, stream, a); break;
            case 2: hipLaunchKernelGGL(ck::c2, dim3(64), dim3(256), 0, stream, a); break;
            case 3: hipLaunchKernelGGL(ck::c3, dim3(64), dim3(256), 0, stream, a); break;
            case 4: hipLaunchKernelGGL(ck::c4, dim3(64), dim3(256), 0, stream, a); break;
            case 5: hipLaunchKernelGGL(ck::c5, dim3(64), dim3(256), 0, stream, a); break;
            case 6: hipLaunchKernelGGL(ck::c6, dim3(64), dim3(256), 0, stream, a); break;
            case 7: hipLaunchKernelGGL(ck::c7, dim3(64), dim3(256), 0, stream, a); break;
            case 8: hipLaunchKernelGGL(ck::c8, dim3(64), dim3(256), 0, stream, a); break;
            default: break;
        }
    }
    float* acc2 = (float*)((char*)d_ws + WS_CTL) + 1024;
    hipLaunchKernelGGL(ck::c9, dim3(1024), dim3(256), 0, stream, a, (const float*)d_out, acc2);
    hipLaunchKernelGGL(ck::report, dim3(1024), dim3(256), 0, stream, a, (float*)d_out, (const float*)acc2, MK_DEBUG_USE_MEGA);
#else
    (void)hipMemsetAsync(d_ws, 0, ZERO_BYTES, stream);
    a.xo = (float*)d_out; a.ph_lo = 0; a.ph_hi = N_PHASES;
    hipLaunchKernelGGL(mk_fwd, dim3(grid), dim3(NTHR), LDS_BYTES, stream, a);
#endif
}
```

```cpp
#include <hip/hip_runtime.h>
#include <cstdio>
#include <cstdint>
#define MK_DEBUG 0
#define MK_TIMING 0
#define GAS __attribute__((address_space(1)))
#define LAS __attribute__((address_space(3)))
typedef unsigned short bf16;
typedef unsigned short bf16_t;
typedef short bf16x8 __attribute__((ext_vector_type(8)));
typedef short s16x4 __attribute__((ext_vector_type(4)));
typedef float f32x4 __attribute__((ext_vector_type(4)));
typedef float f32x2 __attribute__((ext_vector_type(2)));
typedef float f32x16 __attribute__((ext_vector_type(16)));
typedef unsigned u32x4 __attribute__((ext_vector_type(4)));
typedef unsigned u32x2 __attribute__((ext_vector_type(2)));

constexpr int T = 32768, DM = 1024, NB = 16, SEQ = 2048;
constexpr float RMS_EPS = 1e-6f;
constexpr float QSCALE = 0.10206207261596575f * 1.4426950408889634f;
constexpr int NEXP = 32, LIST_CAP = 65536;
constexpr int ACT_ROWS = 65536 + 32 * 256;

constexpr size_t MiB = 1u << 20;
constexpr size_t WS_CTL = 0;
constexpr size_t WS_MOD = 1 * MiB;
constexpr size_t ZERO_BYTES = 2 * MiB;
constexpr size_t WS_ROPE = 2 * MiB;
constexpr size_t WS_WIN = 6 * MiB;
constexpr size_t WS_WUQ = 10 * MiB;
constexpr size_t WS_WUKV = 10 * MiB + 512 * 1024;
constexpr size_t WS_WOUT = 11 * MiB;
constexpr size_t WS_WGU = 13 * MiB;
constexpr size_t WS_WD = 45 * MiB;
constexpr size_t WS_SSQQ = 61 * MiB;
constexpr size_t WS_SSQKV = 61 * MiB + 512 * 1024;
constexpr size_t WS_SSQA = 62 * MiB;
constexpr size_t WS_LTOK = 63 * MiB;
constexpr size_t WS_LW = 71 * MiB;
constexpr size_t WS_ROUTE = 79 * MiB;
constexpr size_t WS_H = 80 * MiB;
constexpr size_t WS_QC = 144 * MiB;
constexpr size_t WS_KVX = 160 * MiB;
constexpr size_t WS_Z = 176 * MiB;
constexpr size_t WS_BG = 208 * MiB;
constexpr size_t WS_Q = 240 * MiB;
constexpr size_t WS_K = 288 * MiB;
constexpr size_t WS_V = 320 * MiB;
constexpr size_t WS_KR = 352 * MiB;
constexpr size_t WS_ACT = 144 * MiB;
constexpr size_t WS_Y = 180 * MiB;
constexpr size_t WS_X1DBG = 360 * MiB;
constexpr size_t WS_END = 488 * MiB;
constexpr int CW_CNT = 8192;
#define CNT_IDX(e) ((e) * 64)
constexpr int CW_ERR = 256;
constexpr int CW_BAR = 4096;

__device__ __forceinline__ unsigned f2bf(float f) { unsigned u = __builtin_bit_cast(unsigned, f); return (u + 0x7fffu + ((u >> 16) & 1u)) >> 16; }
__device__ __forceinline__ unsigned pk2(float lo, float hi) { return f2bf(lo) | (f2bf(hi) << 16); }
__device__ __forceinline__ float bf2f(unsigned short b) { return __builtin_bit_cast(float, (unsigned)b << 16); }
__device__ __forceinline__ float wave_sum(float v) {
#pragma unroll
    for (int o = 32; o > 0; o >>= 1) v += __shfl_xor(v, o);
    return v;
}
__device__ __forceinline__ float silu_f(float a) { return a / (1.f + __expf(-a)); }
#define LDS_WAIT() asm volatile("s_waitcnt lgkmcnt(0)" ::: "memory")
#define VM_WAIT() asm volatile("s_waitcnt vmcnt(0)" ::: "memory")
namespace pg8 {
#define PG8_LAS __attribute__((address_space(3)))
constexpr int BM = 256, BK = 64, HALF = 128, HTB = HALF * BK * 2, STAGE_BYTES = 8 * HTB, NXCD = 8, WGM = 8;
__host__ __device__ __forceinline__ int lds_byte(int r, int c) { const int st = (r >> 4) * 2 + (c >> 5), rr = r & 15, cc = c & 31, ob = rr * 64 + cc * 2; return st * 1024 + (ob ^ (((ob >> 9) & 1) << 5)); }
__host__ __device__ __forceinline__ void stage_rc(int b, int& R, int& C) { const int st = b / 1024, sb = b % 1024, swz = sb ^ (((sb >> 9) & 1) << 5); R = (st >> 1) * 16 + swz / 64; C = (st & 1) * 32 + (swz % 64) / 2; }
__host__ __device__ __forceinline__ int perm32(int rho) { const int n = rho >> 4, i = rho & 15; return 8 * (i >> 2) + 4 * n + (i & 3); }

struct Unit { int pm, pn, e, r0; };
struct Gemm { const bf16_t* A; const bf16_t* Bt; int K; };

struct StaticOrder {
    int nM, nN, nwg, G, c;
    __device__ void init(int M, int N, int G_, int c_) { nM = M / BM; nN = N / BM; nwg = nM * nN; G = G_; c = c_; }
    __device__ bool next(int i, Unit& u) const {
        const long L = (long)i * G + c; if (L >= nwg) return false;
        int wgid = (int)L; { const int q = nwg / NXCD, r = nwg % NXCD, xcd = wgid % NXCD, off = wgid / NXCD; wgid = (xcd < r ? xcd * (q + 1) : r * (q + 1) + (xcd - r) * q) + off; }
        const int nig = WGM * nN, gid = wgid / nig, fm = gid * WGM, gsz = (nM - fm) < WGM ? (nM - fm) : WGM;
        u.pm = fm + ((wgid % nig) % gsz); u.pn = (wgid % nig) / gsz; u.e = 0; u.r0 = 0; return true;
    }
    static constexpr bool GATHER = false;
    __device__ __forceinline__ int arow(const Unit& u, int rloc) const { return u.pm * BM + rloc; }
};

__device__ __forceinline__ unsigned cvt_pk_bf16(float lo, float hi) { unsigned r; asm volatile("v_cvt_pk_bf16_f32 %0, %1, %2" : "=v"(r) : "v"(lo), "v"(hi)); return r; }

template <class Epi, class Sched, bool ALIGN_EPI>
__device__ __forceinline__ void gemm_phase(PG8_LAS unsigned char* lds, const Gemm g, const Sched& S, const Epi& E) {
    const int tid = threadIdx.x, wid = __builtin_amdgcn_readfirstlane(tid >> 6), lane = tid & 63, wr = wid >> 2, wc = wid & 3, fr = lane & 15, fq = lane >> 4;
    const int K = g.K, nt = K / BK;
    unsigned voffA[2], voffB[2];
#pragma unroll
    for (int i = 0; i < 2; ++i) { int R, C; stage_rc(tid * 16 + i * 8192, R, C); const int Rb = Epi::PERM ? ((R & ~31) + perm32(R & 31)) : R;
        voffA[i] = (unsigned)(R * K + C) * 2u; voffB[i] = (unsigned)(Rb * K + C) * 2u; }
    const size_t kstep = (size_t)(BK * 2);
    const size_t hstep = (size_t)HALF * K * 2;
    const size_t tstep = 2 * hstep;
    const unsigned ldsw = (unsigned)wid * 1024u;
    const int aoff = lds_byte(wr * 64 + fr, fq * 8), boff = lds_byte(wc * 32 + fr, fq * 8);
#define PG8_SA(b, h) (((b) * 2 + (h)) * HTB)
#define PG8_SB(b, h) ((4 + (b) * 2 + (h)) * HTB)
#define PG8_STAGE(bufoff, gbase, voff) do { _Pragma("unroll") for (int _i = 0; _i < 2; ++_i) \
        __builtin_amdgcn_global_load_lds((const unsigned*)((const char*)(gbase) + (voff)[_i]), (PG8_LAS unsigned*)(lds + (bufoff) + ldsw + _i * 8192), 16, 0, 0); } while (0)
#define PG8_STAGE_A(bufoff, h, kb, usenext) do { _Pragma("unroll") for (int _i = 0; _i < 2; ++_i) { const char* _p; \
        if constexpr (Sched::GATHER) _p = (const char*)g.A + (size_t)(kb) + ((usenext) ? nvA[h][_i] : vA[h][_i]); \
        else _p = ((usenext) ? nA : cA) + (size_t)(kb) + (size_t)(h) * hstep + voffA[_i]; \
        __builtin_amdgcn_global_load_lds((const unsigned*)_p, (PG8_LAS unsigned*)(lds + (bufoff) + ldsw + _i * 8192), 16, 0, 0); } } while (0)
#define PG8_LDA(dst, b, h) do { _Pragma("unroll") for (int m = 0; m < 4; ++m) _Pragma("unroll") for (int k = 0; k < 2; ++k) dst[m][k] = *(const PG8_LAS bf16x8*)(lds + PG8_SA(b, h) + aoff + m * 2048 + k * 1024); } while (0)
#define PG8_LDB(dst, b, h) do { _Pragma("unroll") for (int n = 0; n < 2; ++n) _Pragma("unroll") for (int k = 0; k < 2; ++k) dst[n][k] = *(const PG8_LAS bf16x8*)(lds + PG8_SB(b, h) + boff + n * 2048 + k * 1024); } while (0)
#define PG8_MMA(ai, bj, At, Bt) do { __builtin_amdgcn_s_setprio(1); _Pragma("unroll") for (int m = 0; m < 4; ++m) _Pragma("unroll") for (int n = 0; n < 2; ++n) _Pragma("unroll") for (int k = 0; k < 2; ++k) \
        acc[ai][bj][m][n] = __builtin_amdgcn_mfma_f32_16x16x32_bf16(Bt[n][k], At[m][k], acc[ai][bj][m][n], 0, 0, 0); __builtin_amdgcn_s_setprio(0); } while (0)
#define PG8_WAIT_V(n) asm volatile("s_waitcnt vmcnt(" #n ")" ::: "memory")
#define PG8_WAIT_L(n) asm volatile("s_waitcnt lgkmcnt(" #n ")" ::: "memory")
#define PG8_BAR __builtin_amdgcn_s_barrier()
#define PG8_SCHED __builtin_amdgcn_sched_barrier(0)
#define PG8_SETVO(vo, u) do { _Pragma("unroll") for (int _i = 0; _i < 2; ++_i) { int R_, C_; stage_rc(tid * 16 + _i * 8192, R_, C_); \
        _Pragma("unroll") for (int _h = 0; _h < 2; ++_h) vo[_h][_i] = ((unsigned)S.arow(u, _h * HALF + R_) * (unsigned)K + (unsigned)C_) * 2u; } } while (0)
    Unit cur, nxt; int ui = 0;
    if (!S.next(0, cur)) return;
    f32x4 acc[2][2][4][2];
#pragma unroll
    for (int a = 0; a < 2; ++a)
#pragma unroll
        for (int b = 0; b < 2; ++b)
#pragma unroll
            for (int m = 0; m < 4; ++m)
#pragma unroll
                for (int n = 0; n < 2; ++n) acc[a][b][m][n] = (f32x4){0.f, 0.f, 0.f, 0.f};
    bf16x8 At[4][2], B0[2][2], B1[2][2];
    unsigned vA[2][2], nvA[2][2];
    const char* cA = (const char*)g.A; const char* nA = cA;
    if constexpr (Sched::GATHER) { PG8_SETVO(vA, cur); } else { cA = (const char*)g.A + (size_t)S.arow(cur, 0) * K * 2; }
    const char* cB = (const char*)g.Bt + (size_t)cur.pn * tstep;
    PG8_STAGE(PG8_SB(0, 0), cB, voffB); PG8_STAGE(PG8_SB(0, 1), cB + hstep, voffB); PG8_STAGE_A(PG8_SA(0, 0), 0, 0, false); PG8_STAGE_A(PG8_SA(0, 1), 1, 0, false);
    if (wr == 1) PG8_BAR;
    PG8_WAIT_V(2); PG8_BAR;
    PG8_STAGE(PG8_SB(1, 0), cB + kstep, voffB); PG8_STAGE_A(PG8_SA(1, 0), 0, kstep, false); PG8_STAGE(PG8_SB(1, 1), cB + hstep + kstep, voffB);
    PG8_WAIT_V(6); PG8_BAR;
    for (;;) {
        const bool has_next = S.next(ui + 1, nxt);
        if constexpr (Sched::GATHER) {
            if (has_next) { PG8_SETVO(nvA, nxt); } else {
#pragma unroll
                for (int _h = 0; _h < 2; ++_h)
#pragma unroll
                    for (int _i = 0; _i < 2; ++_i) nvA[_h][_i] = vA[_h][_i]; }
        } else { nA = has_next ? (const char*)g.A + (size_t)S.arow(nxt, 0) * K * 2 : cA; }
        const char* nB = has_next ? (const char*)g.Bt + (size_t)nxt.pn * tstep : cB;
#pragma nounroll
        for (int t = 0; t < nt; t += 2) {
            const bool last = (t == nt - 2);
            if constexpr (Epi::HAS_MID) { if (t == Epi::MID_T) E.mid(acc, cur, wr, wc, fr, fq); }
            const size_t k1 = (size_t)(t + 1) * kstep;
            const size_t k2 = last ? 0 : (size_t)(t + 2) * kstep, k3 = k2 + kstep;
            const char* b2 = last ? nB : cB + (size_t)(t + 2) * kstep; const char* b3 = b2 + kstep;
            PG8_LDB(B0, 0, 0); PG8_LDB(B1, 0, 1); PG8_SCHED; PG8_LDA(At, 0, 0); PG8_STAGE_A(PG8_SA(1, 1), 1, k1, false);
            PG8_WAIT_V(8); PG8_WAIT_L(0); PG8_BAR; PG8_MMA(0, 0, At, B0); PG8_MMA(0, 1, At, B1); PG8_BAR; PG8_SCHED;
            PG8_LDA(At, 0, 1); PG8_STAGE(PG8_SB(0, 0), b2, voffB); PG8_STAGE(PG8_SB(0, 1), b2 + hstep, voffB); PG8_STAGE_A(PG8_SA(0, 0), 0, k2, last);
            PG8_WAIT_V(8); PG8_WAIT_L(0); PG8_BAR; PG8_MMA(1, 0, At, B0); PG8_MMA(1, 1, At, B1); PG8_BAR; PG8_SCHED;
            PG8_LDB(B0, 1, 0); PG8_LDB(B1, 1, 1); PG8_SCHED; PG8_LDA(At, 1, 0); PG8_STAGE_A(PG8_SA(0, 1), 1, k2, last);
            PG8_WAIT_V(8); PG8_WAIT_L(0); PG8_BAR; PG8_MMA(0, 0, At, B0); PG8_MMA(0, 1, At, B1); PG8_BAR; PG8_SCHED;
            PG8_LDA(At, 1, 1); PG8_STAGE(PG8_SB(1, 0), b3, voffB); PG8_STAGE(PG8_SB(1, 1), b3 + hstep, voffB); PG8_STAGE_A(PG8_SA(1, 0), 0, k3, last);
            PG8_WAIT_V(8); PG8_WAIT_L(0); PG8_BAR; PG8_MMA(1, 0, At, B0); PG8_MMA(1, 1, At, B1); PG8_BAR; PG8_SCHED;
        }
        if constexpr (ALIGN_EPI) { if (wr == 0) PG8_BAR; }
        E(acc, cur, wr, wc, fr, fq);
        if (!has_next) break;
#pragma unroll
        for (int a = 0; a < 2; ++a)
#pragma unroll
            for (int b = 0; b < 2; ++b)
#pragma unroll
                for (int m = 0; m < 4; ++m)
#pragma unroll
                    for (int n = 0; n < 2; ++n) acc[a][b][m][n] = (f32x4){0.f, 0.f, 0.f, 0.f};
        cur = nxt; cB = nB; cA = nA; ++ui;
        if constexpr (Sched::GATHER) {
#pragma unroll
            for (int _h = 0; _h < 2; ++_h)
#pragma unroll
                for (int _i = 0; _i < 2; ++_i) vA[_h][_i] = nvA[_h][_i]; }
        if constexpr (ALIGN_EPI) { if (wr == 1) PG8_BAR; }
    }
    PG8_WAIT_V(0);
    if constexpr (!ALIGN_EPI) { if (wr == 0) PG8_BAR; }
    PG8_BAR;
#undef PG8_SA
#undef PG8_SB
#undef PG8_STAGE
#undef PG8_STAGE_A
#undef PG8_LDA
#undef PG8_LDB
#undef PG8_MMA
#undef PG8_WAIT_V
#undef PG8_WAIT_L
#undef PG8_BAR
#undef PG8_SCHED
#undef PG8_SETVO
}
}
#define XB_TMO      128
#define XB_XCNT(j)  (256  + 64 * (j))
#define XB_XSUB(j)  (1280 + 64 * (j))
#define XB_XGEN(j)  (2304 + 64 * (j))
#define XB_TOP      3328
#define XB_TOPGEN   3392
#define XCD_BAR_WORDS 3456
#define XB_SPIN_CAP (1u << 22)
__device__ __forceinline__ unsigned xb_ld(unsigned* p)              { return __hip_atomic_load(p, __ATOMIC_RELAXED, __HIP_MEMORY_SCOPE_AGENT); }
__device__ __forceinline__ unsigned xb_add(unsigned* p, unsigned v) { return __hip_atomic_fetch_add(p, v, __ATOMIC_RELAXED, __HIP_MEMORY_SCOPE_AGENT); }
__device__ __forceinline__ unsigned xb_xcc_id() { return (unsigned)__builtin_amdgcn_s_getreg((3 << 11) | 20) & 0xFu; }
#define XB_SPIN(cond, bar) do { unsigned _sp = 0; while (cond) { __builtin_amdgcn_s_sleep(1); \
    if ((++_sp & 255u) == 0u) { if (xb_ld(&(bar)[XB_TMO])) break; if (_sp > XB_SPIN_CAP) { atomicAdd(&(bar)[XB_TMO], 1u); break; } } } } while (0)
struct XcdBarrier { unsigned* bar; unsigned x; volatile LAS unsigned* st; };
__device__ __forceinline__ XcdBarrier xcd_barrier_post(unsigned* bar, volatile LAS unsigned* st) {
    XcdBarrier b; b.bar = bar; b.x = xb_xcc_id(); b.st = st;
    if (threadIdx.x == 0) (void)xb_add(&bar[XB_XCNT(b.x)], 1u);
    return b;
}
__device__ __forceinline__ void xcd_barrier_complete(unsigned* bar, unsigned x, unsigned& nloc, unsigned& nx) {
    const unsigned G = gridDim.x * gridDim.y * gridDim.z;
    unsigned sum, cnt, mine, sp = 0u;
    for (;;) {
        sum = 0u; cnt = 0u; mine = 0u;
#pragma unroll
        for (unsigned j = 0; j < 16; ++j) { const unsigned c = xb_ld(&bar[XB_XCNT(j)]); sum += c; cnt += (c > 0u) ? 1u : 0u; mine = (j == x) ? c : mine; }
        if (sum == G) break;
        __builtin_amdgcn_s_sleep(1);
        if ((++sp & 255u) == 0u) { if (xb_ld(&bar[XB_TMO])) break; if (sp > XB_SPIN_CAP) { atomicAdd(&bar[XB_TMO], 1u); break; } }
    }
    nloc = mine > 0u ? mine : 1u; nx = cnt > 0u ? cnt : 1u;
}
__device__ __forceinline__ void xcd_barrier(const XcdBarrier& b) {
    asm volatile("s_waitcnt vmcnt(0)" ::: "memory");
    __syncthreads();
    if (threadIdx.x == 0) {
        unsigned* bar = b.bar;
        __builtin_amdgcn_s_waitcnt(0);
        unsigned nloc = b.st[0], nx = b.st[1];
        if (nloc == 0u) { xcd_barrier_complete(bar, b.x, nloc, nx); b.st[0] = nloc; b.st[1] = nx; }
        const unsigned old = xb_add(&bar[XB_XSUB(b.x)], 1u);
        const unsigned gen = old / nloc;
        if (old + 1u == (gen + 1u) * nloc) {
            __builtin_amdgcn_fence(__ATOMIC_RELEASE, "agent");
            asm volatile("s_waitcnt vmcnt(0)" ::: "memory");
            const unsigned og = xb_add(&bar[XB_TOP], 1u);
            const unsigned tg = og / nx;
            if (og + 1u == (tg + 1u) * nx) xb_add(&bar[XB_TOPGEN], 1u);
            else XB_SPIN(xb_ld(&bar[XB_TOPGEN]) == tg, bar);
            __builtin_amdgcn_fence(__ATOMIC_ACQUIRE, "agent");
            xb_add(&bar[XB_XGEN(b.x)], 1u);
            asm volatile("s_waitcnt vmcnt(0)" ::: "memory");
        } else {
            XB_SPIN(xb_ld(&bar[XB_XGEN(b.x)]) == gen, bar);
            __builtin_amdgcn_fence(__ATOMIC_ACQUIRE, "agent");
            asm volatile("s_waitcnt vmcnt(0)" ::: "memory");
        }
    }
    __syncthreads();
}

struct MKArgs { const float* in[26]; float* xo; unsigned char* ws; int ph_lo, ph_hi; };
constexpr int NWAVES = 8, NTHR = 512;
constexpr int LDS_BYTES = 163840;
constexpr int MISC_OFF = 163840 - 512;

struct Frame {
    LAS unsigned char* lds; int tid, lane, wave, bid, G, vcu; unsigned char* ws;
};
#define INP(i) (A.in[i])

__device__ __forceinline__ void tr_item(const float* W, int ldw, int scol0, bf16* WT, int ldt, int drow0, int k0, const float* kscale, float mul, LAS float* scr, int lane) {
    if (W) {
#pragma unroll 8
        for (int i = 0; i < 32; ++i) { const int kk = 2 * i + (lane >> 5); float v = W[(size_t)(k0 + kk) * ldw + scol0 + (lane & 31)];
            if (kscale) v *= kscale[k0 + kk]; scr[kk * 33 + (lane & 31)] = v * mul; }
    } else {
#pragma unroll 8
        for (int i = 0; i < 32; ++i) { const int kk = 2 * i + (lane >> 5); scr[kk * 33 + (lane & 31)] = 0.f; }
    }
    LDS_WAIT(); asm volatile("" ::: "memory");
    const int c = lane & 7;
#pragma unroll
    for (int j = 0; j < 4; ++j) { const int n = (lane >> 3) + 8 * j; const LAS float* s = scr + (8 * c) * 33 + n;
        u32x4 o; o.x = pk2(s[0 * 33], s[1 * 33]); o.y = pk2(s[2 * 33], s[3 * 33]); o.z = pk2(s[4 * 33], s[5 * 33]); o.w = pk2(s[6 * 33], s[7 * 33]);
        *(u32x4*)(WT + (size_t)(drow0 + n) * ldt + k0 + 8 * c) = o; }
    LDS_WAIT(); asm volatile("" ::: "memory");
}
__device__ __forceinline__ int win_src(int n0) {
    if (n0 < 256) return n0;
    if (n0 < 384) return 256 + (n0 - 256);
    if (n0 < 416) return 384 + (n0 - 384);
    if (n0 < 512) return -1;
    if (n0 < 1536) { const int p = (n0 - 512) >> 8, j = (n0 - 512) & 255; return j < 128 ? 416 + 128 * p + j : 1440 + 128 * p + (j - 128); }
    return 928 + (n0 - 1536);
}
__device__ __forceinline__ void phase0(Frame& F, const MKArgs& A) {
    const float* c = INP(1); const int* pos = (const int*)INP(2); const float* w_ada = INP(3); const float* b_ada = INP(4);
    float* mod = (float*)(F.ws + WS_MOD);
    for (int it = F.bid; it < 192; it += F.G) {
        const int cg = it % 96, kh = it / 96, k0 = kh * 512;
        LAS float* cact = (LAS float*)F.lds;
        LAS float* red = (LAS float*)(F.lds + 32768);
        for (int i = F.tid; i < 16 * 512; i += NTHR) { const int b = i >> 9, k = i & 511; cact[i] = silu_f(c[b * DM + k0 + k]); }
        __syncthreads();
        float acc[16];
#pragma unroll
        for (int b = 0; b < 16; ++b) acc[b] = 0.f;
        const int n = cg * 64 + F.lane; const float* wp = w_ada + (size_t)(k0 + F.wave * 64) * 6144 + n;
#pragma unroll 8
        for (int kk = 0; kk < 64; ++kk) { const float wv = wp[(size_t)kk * 6144];
#pragma unroll
            for (int b = 0; b < 16; ++b) acc[b] += cact[b * 512 + F.wave * 64 + kk] * wv; }
#pragma unroll
        for (int b = 0; b < 16; ++b) red[(F.wave * 16 + b) * 64 + F.lane] = acc[b];
        __syncthreads();
        for (int o = F.tid; o < 1024; o += NTHR) { const int b = o >> 6, l = o & 63; float s = 0.f;
#pragma unroll
            for (int w = 0; w < 8; ++w) s += red[(w * 16 + b) * 64 + l];
            if (kh == 0) s += b_ada[cg * 64 + l];
            atomicAdd(&mod[b * 6144 + cg * 64 + l], s); }
        __syncthreads();
    }
    __syncthreads();
    LAS float* scr = (LAS float*)(F.lds + F.wave * 16384);
    const int gw = F.vcu * NWAVES + F.wave, NGW = F.G * NWAVES;
    constexpr int I_WIN = 64 * 16, I_UQ = 24 * 4, I_UKV = 32 * 4, I_OUT = 32 * 16, I_GU = 32 * 16 * 16, I_D = 32 * 32 * 4;
    constexpr int NITEMS = I_WIN + I_UQ + I_UKV + I_OUT + I_GU + I_D;
    for (int it = gw; it < NITEMS; it += NGW) {
        int r = it;
        if (r < I_WIN) { const int nb = r >> 4, kb = r & 15; const int sc = win_src(nb * 32);
            tr_item(sc >= 0 ? INP(6) : nullptr, 1952, sc, (bf16*)(F.ws + WS_WIN), 1024, nb * 32, kb * 64, nullptr, 1.f, scr, F.lane); continue; } r -= I_WIN;
        if (r < I_UQ) { const int nb = r >> 2, kb = r & 3;
            tr_item(INP(9), 768, nb * 32, (bf16*)(F.ws + WS_WUQ), 256, nb * 32, kb * 64, INP(7), QSCALE, scr, F.lane); continue; } r -= I_UQ;
        if (r < I_UKV) { const int nb = r >> 2, kb = r & 3; const float* src = kb < 2 ? (nb < 16 ? INP(10) : INP(11)) : nullptr;
            tr_item(src, 512, (nb & 15) * 32, (bf16*)(F.ws + WS_WUKV), 256, nb * 32, kb * 64, INP(8), 1.f, scr, F.lane); continue; } r -= I_UKV;
        if (r < I_OUT) { const int nb = r >> 4, kb = r & 15; const float* ks = kb < 8 ? INP(14) : INP(15) - 512;
            tr_item(INP(16), 1024, nb * 32, (bf16*)(F.ws + WS_WOUT), 1024, nb * 32, kb * 64, ks, 1.f, scr, F.lane); continue; } r -= I_OUT;
        if (r < I_GU) { const int e = r >> 8, nb = (r >> 4) & 15, kb = r & 15; const int p = nb >> 3, j0 = (nb & 7) * 32;
            const float* src = (j0 < 128 ? INP(22) : INP(23)) + (size_t)e * 1024 * 256; const int sc = 128 * p + (j0 & 127);
            tr_item(src, 256, sc, (bf16*)(F.ws + WS_WGU), 1024, e * 512 + nb * 32, kb * 64, nullptr, 1.f, scr, F.lane); continue; } r -= I_GU;
        { const int e = r >> 7, nb = (r >> 2) & 31, kb = r & 3;
            tr_item(INP(24) + (size_t)e * 256 * 1024, 1024, nb * 32, (bf16*)(F.ws + WS_WD), 256, e * 1024 + nb * 32, kb * 64, nullptr, 1.f, scr, F.lane); }
    }
    float* cs = (float*)(F.ws + WS_ROPE); float* sn = cs + (size_t)T * 16;
    for (int i = F.bid * NTHR + F.tid; i < T * 16; i += F.G * NTHR) { const int t = i >> 4, j = i & 15;
        const float invf = 1.0f / powf(10000.0f, (float)(2 * j) / 32.0f); const float ang = (float)pos[t] * invf;
        cs[i] = cosf(ang); sn[i] = sinf(ang); }
}

__device__ __forceinline__ void phase1(Frame& F, const MKArgs& A) {
    const float* x = INP(0); const float* g = INP(5); const float* mod = (const float*)(F.ws + WS_MOD);
    bf16* H = (bf16*)(F.ws + WS_H);
    LAS float* Gs = (LAS float*)F.lds; LAS float* Ss = Gs + 1024;
    for (int blk = F.bid; blk < T / 128; blk += F.G) {
        const int b = (blk * 128) / SEQ;
        __syncthreads();
        for (int k = F.tid; k < 1024; k += NTHR) { Gs[k] = g[k] * (1.f + mod[b * 6144 + 1024 + k]); Ss[k] = mod[b * 6144 + k]; }
        __syncthreads();
        for (int rr = F.wave; rr < 128; rr += NWAVES) {
            const int row = blk * 128 + rr;
            const f32x4* xr = (const f32x4*)(x + (size_t)row * DM) + F.lane;
            f32x4 v[4]; float s = 0.f;
#pragma unroll
            for (int j = 0; j < 4; ++j) { v[j] = xr[64 * j]; s += (v[j].x * v[j].x + v[j].y * v[j].y) + (v[j].z * v[j].z + v[j].w * v[j].w); }
            const float r = rsqrtf(wave_sum(s) * (1.f / DM) + RMS_EPS);
            unsigned long long* o8 = (unsigned long long*)(H + (size_t)row * DM) + F.lane;
#pragma unroll
            for (int j = 0; j < 4; ++j) { const f32x4 gg = *(const LAS f32x4*)(Gs + 4 * F.lane + 256 * j), ss = *(const LAS f32x4*)(Ss + 4 * F.lane + 256 * j);
                const f32x4 h = v[j] * r * gg + ss;
                o8[64 * j] = (unsigned long long)pk2(h.x, h.y) | ((unsigned long long)pk2(h.z, h.w) << 32); }
        }
    }
}

using pg8::Unit; using pg8::cvt_pk_bf16;
#define PK4(v0, v1) (u32x4){cvt_pk_bf16((v0)[0], (v0)[1]), cvt_pk_bf16((v0)[2], (v0)[3]), cvt_pk_bf16((v1)[0], (v1)[1]), cvt_pk_bf16((v1)[2], (v1)[3])}
__device__ __forceinline__ void rope_group(f32x4& v0, f32x4& v1, const float* cs, const float* sn, int row, int fq) {
    const int i0 = 8 * (fq & 1);
    const f32x4 c0 = *(const f32x4*)(cs + (size_t)row * 16 + i0), c1 = *(const f32x4*)(cs + (size_t)row * 16 + i0 + 4);
    const f32x4 s0 = *(const f32x4*)(sn + (size_t)row * 16 + i0), s1 = *(const f32x4*)(sn + (size_t)row * 16 + i0 + 4);
    const float sg = fq < 2 ? -1.f : 1.f;
#pragma unroll
    for (int e = 0; e < 4; ++e) { const float o0 = __shfl_xor(v0[e], 32), o1 = __shfl_xor(v1[e], 32);
        v0[e] = v0[e] * c0[e] + sg * o0 * s0[e]; v1[e] = v1[e] * c1[e] + sg * o1 * s1[e]; }
}
struct EpiP2 {
    static constexpr bool PERM = true, HAS_MID = false; static constexpr int MID_T = 0;
    bf16* qc; bf16* kvx; bf16* z; bf16* bg; bf16* kr; float* ssqq; float* ssqkv; const float* cs; const float* sn;
    __device__ __forceinline__ void mid(f32x4 (&)[2][2][4][2], const Unit&, int, int, int, int) const {}
    __device__ __forceinline__ void operator()(f32x4 (&acc)[2][2][4][2], const Unit& u, int wr, int wc, int fr, int fq) const {
        const int pn = u.pn, rowb = u.pm * 256 + wr * 64 + fr, cl = wc * 32 + 8 * fq;
        if (pn == 0) {
#pragma unroll
            for (int ai = 0; ai < 2; ++ai)
#pragma unroll
                for (int m = 0; m < 4; ++m) { const int row = rowb + ai * 128 + m * 16; float ss = 0.f;
#pragma unroll
                    for (int bj = 0; bj < 2; ++bj) { const f32x4 v0 = acc[ai][bj][m][0], v1 = acc[ai][bj][m][1];
                        ss += (v0[0] * v0[0] + v0[1] * v0[1]) + (v0[2] * v0[2] + v0[3] * v0[3]) + (v1[0] * v1[0] + v1[1] * v1[1]) + (v1[2] * v1[2] + v1[3] * v1[3]);
                        *(u32x4*)(qc + (size_t)row * 256 + bj * 128 + cl) = PK4(v0, v1); }
                    ss += __shfl_xor(ss, 16); ss += __shfl_xor(ss, 32);
                    if (fq == 0) ssqq[(size_t)row * 4 + wc] = ss; }
        } else if (pn == 1) {
#pragma unroll
            for (int ai = 0; ai < 2; ++ai)
#pragma unroll
                for (int m = 0; m < 4; ++m) { const int row = rowb + ai * 128 + m * 16;
                    f32x4 v0 = acc[ai][0][m][0], v1 = acc[ai][0][m][1];
                    float ss = (v0[0] * v0[0] + v0[1] * v0[1]) + (v0[2] * v0[2] + v0[3] * v0[3]) + (v1[0] * v1[0] + v1[1] * v1[1]) + (v1[2] * v1[2] + v1[3] * v1[3]);
                    *(u32x4*)(kvx + (size_t)row * 256 + cl) = PK4(v0, v1);
                    ss += __shfl_xor(ss, 16); ss += __shfl_xor(ss, 32);
                    if (fq == 0) ssqkv[(size_t)row * 4 + wc] = ss;
                    v0 = acc[ai][1][m][0]; v1 = acc[ai][1][m][1];
                    *(u32x4*)(kvx + (size_t)row * 256 + 128 + cl) = PK4(v0, v1);
                    if (wc == 0) { rope_group(v0, v1, cs, sn, row, fq); *(u32x4*)(kr + (size_t)row * 32 + 8 * fq) = PK4(v0, v1); }
                    asm volatile("" ::: "memory"); }
        } else if (pn < 6) {
            const int p = pn - 2;
#pragma unroll
            for (int ai = 0; ai < 2; ++ai)
#pragma unroll
                for (int m = 0; m < 4; ++m) { const int row = rowb + ai * 128 + m * 16;
                    const f32x4 v0 = acc[ai][0][m][0] * acc[ai][1][m][0], v1 = acc[ai][0][m][1] * acc[ai][1][m][1];
                    *(u32x4*)(z + (size_t)row * 512 + 128 * p + cl) = PK4(v0, v1); }
        } else {
            const int p = pn - 6;
#pragma unroll
            for (int ai = 0; ai < 2; ++ai)
#pragma unroll
                for (int m = 0; m < 4; ++m) { const int row = rowb + ai * 128 + m * 16;
#pragma unroll
                    for (int bj = 0; bj < 2; ++bj) { const f32x4 v0 = acc[ai][bj][m][0], v1 = acc[ai][bj][m][1];
                        *(u32x4*)(bg + (size_t)row * 512 + 256 * p + bj * 128 + cl) = PK4(v0, v1); } }
        }
    }
};
struct EpiQ {
    static constexpr bool PERM = true, HAS_MID = false; static constexpr int MID_T = 0;
    bf16* Q; const float* ssqq; const float* cs; const float* sn;
    __device__ __forceinline__ void mid(f32x4 (&)[2][2][4][2], const Unit&, int, int, int, int) const {}
    __device__ __forceinline__ void operator()(f32x4 (&acc)[2][2][4][2], const Unit& u, int wr, int wc, int fr, int fq) const {
        const int pn = u.pn, rowb = u.pm * 256 + wr * 64 + fr, cl = wc * 32 + 8 * fq;
#pragma unroll
        for (int ai = 0; ai < 2; ++ai)
#pragma unroll
            for (int m = 0; m < 4; ++m) { const int row = rowb + ai * 128 + m * 16;
                const f32x4 sq = *(const f32x4*)(ssqq + (size_t)row * 4);
                const float rq = rsqrtf(((sq[0] + sq[1]) + (sq[2] + sq[3])) * (1.f / 256.f) + RMS_EPS);
#pragma unroll
                for (int bj = 0; bj < 2; ++bj) { const int col32 = 8 * pn + 4 * bj + wc;
                    f32x4 v0 = acc[ai][bj][m][0] * rq, v1 = acc[ai][bj][m][1] * rq;
                    if ((col32 % 3) == 2) rope_group(v0, v1, cs, sn, row, fq);
                    *(u32x4*)(Q + (size_t)row * 768 + 256 * pn + bj * 128 + cl) = PK4(v0, v1); }
                asm volatile("" ::: "memory"); }
    }
};
struct EpiKV {
    static constexpr bool PERM = true, HAS_MID = false; static constexpr int MID_T = 0;
    bf16* Kb; bf16* Vb; const float* ssqkv;
    __device__ __forceinline__ void mid(f32x4 (&)[2][2][4][2], const Unit&, int, int, int, int) const {}
    __device__ __forceinline__ void operator()(f32x4 (&acc)[2][2][4][2], const Unit& u, int wr, int wc, int fr, int fq) const {
        const int pn = u.pn, rowb = u.pm * 256 + wr * 64 + fr, cl = wc * 32 + 8 * fq;
        bf16* dst = (pn < 2 ? Kb : Vb) + 256 * (pn & 1);
#pragma unroll
        for (int ai = 0; ai < 2; ++ai)
#pragma unroll
            for (int m = 0; m < 4; ++m) { const int row = rowb + ai * 128 + m * 16;
                const f32x4 sq = *(const f32x4*)(ssqkv + (size_t)row * 4);
                const float rk = rsqrtf(((sq[0] + sq[1]) + (sq[2] + sq[3])) * (1.f / 128.f) + RMS_EPS);
#pragma unroll
                for (int bj = 0; bj < 2; ++bj) { const f32x4 v0 = acc[ai][bj][m][0] * rk, v1 = acc[ai][bj][m][1] * rk;
                    *(u32x4*)(dst + (size_t)row * 512 + bj * 128 + cl) = PK4(v0, v1); }
                asm volatile("" ::: "memory"); }
    }
};
struct EpiOut {
    static constexpr bool PERM = false, HAS_MID = true; static constexpr int MID_T = 8;
    const float* x; const float* mod; float* xo; const float* ssqa;
    __device__ __forceinline__ void mid(f32x4 (&acc)[2][2][4][2], const Unit& u, int wr, int wc, int fr, int fq) const {
        const int rowb = u.pm * 256 + wr * 64 + fr;
#pragma unroll
        for (int ai = 0; ai < 2; ++ai)
#pragma unroll
            for (int m = 0; m < 4; ++m) { const int row = rowb + ai * 128 + m * 16;
                const f32x4 a = *(const f32x4*)(ssqa + (size_t)row * 8), b = *(const f32x4*)(ssqa + (size_t)row * 8 + 4);
                const float ra = rsqrtf((((a[0] + a[1]) + (a[2] + a[3])) + ((b[0] + b[1]) + (b[2] + b[3]))) * (1.f / 512.f) + RMS_EPS);
#pragma unroll
                for (int bj = 0; bj < 2; ++bj)
#pragma unroll
                    for (int n = 0; n < 2; ++n) acc[ai][bj][m][n] *= ra; }
    }
    __device__ __forceinline__ void operator()(f32x4 (&acc)[2][2][4][2], const Unit& u, int wr, int wc, int fr, int fq) const {
        const int rowb = u.pm * 256 + wr * 64 + fr, col0 = u.pn * 256 + wc * 32 + 4 * fq; const int b = (u.pm * 256) / SEQ;
        const float* g1 = mod + b * 6144 + 2048;
#pragma unroll
        for (int bj = 0; bj < 2; ++bj)
#pragma unroll
            for (int n = 0; n < 2; ++n) { const int col = col0 + bj * 128 + n * 16; const f32x4 gv = *(const f32x4*)(g1 + col);
#pragma unroll
                for (int ai = 0; ai < 2; ++ai)
#pragma unroll
                    for (int m = 0; m < 4; ++m) { const size_t off = (size_t)(rowb + ai * 128 + m * 16) * DM + col;
                        *(f32x4*)(xo + off) = *(const f32x4*)(x + off) + gv * acc[ai][bj][m][n]; if (m & 1) asm volatile("" ::: "memory"); } }
    }
};
struct EpiAct {
    static constexpr bool PERM = true, HAS_MID = false; static constexpr int MID_T = 0;
    bf16* act;
    __device__ __forceinline__ void mid(f32x4 (&)[2][2][4][2], const Unit&, int, int, int, int) const {}
    __device__ __forceinline__ void operator()(f32x4 (&acc)[2][2][4][2], const Unit& u, int wr, int wc, int fr, int fq) const {
        const int rowb = u.pm * 256 + wr * 64 + fr, cl = wc * 32 + 8 * fq, p = u.pn & 1;
#pragma unroll
        for (int ai = 0; ai < 2; ++ai)
#pragma unroll
            for (int m = 0; m < 4; ++m) { const int row = rowb + ai * 128 + m * 16; f32x4 v0, v1;
#pragma unroll
                for (int e = 0; e < 4; ++e) { v0[e] = silu_f(acc[ai][0][m][0][e]) * acc[ai][1][m][0][e]; v1[e] = silu_f(acc[ai][0][m][1][e]) * acc[ai][1][m][1][e]; }
                *(u32x4*)(act + (size_t)row * 256 + 128 * p + cl) = PK4(v0, v1); }
    }
};
struct EpiDown {
    static constexpr bool PERM = true, HAS_MID = false; static constexpr int MID_T = 0;
    bf16* Y; const int* ltok; const float* lw; const unsigned* cnt;
    __device__ __forceinline__ void mid(f32x4 (&)[2][2][4][2], const Unit&, int, int, int, int) const {}
    __device__ __forceinline__ void operator()(f32x4 (&acc)[2][2][4][2], const Unit& u, int wr, int wc, int fr, int fq) const {
        const int cl = wc * 32 + 8 * fq, pn = u.pn & 3; const int ce = (int)cnt[CNT_IDX(u.e)];
#pragma unroll
        for (int ai = 0; ai < 2; ++ai)
#pragma unroll
            for (int m = 0; m < 4; ++m) { const int slot = u.r0 + ai * 128 + wr * 64 + m * 16 + fr;
                if (slot < ce) { const int tk = ltok[(size_t)u.e * LIST_CAP + slot]; const float w = lw[(size_t)u.e * LIST_CAP + slot];
                    bf16* dst = Y + ((size_t)(tk & 1) * T + (tk >> 1)) * DM + 256 * pn + cl;
#pragma unroll
                    for (int bj = 0; bj < 2; ++bj) { const f32x4 v0 = acc[ai][bj][m][0] * w, v1 = acc[ai][bj][m][1] * w; *(u32x4*)(dst + bj * 128) = PK4(v0, v1); } }
                asm volatile("" ::: "memory"); }
    }
};
template <bool GATHER_> struct MoeOrder {
    static constexpr bool GATHER = GATHER_;
    volatile LAS int* pb; int ntn, G, c; const unsigned* cnt; const int* ltok;
    __device__ __forceinline__ bool next(int i, Unit& u) const {
        const int L = i * G + c; const int total = pb[32] * ntn; if (L >= total) return false;
        const int rb = L / ntn, nt = L - rb * ntn; int e = 0;
        for (int j = 1; j < 32; ++j) e = (pb[j] <= rb) ? j : e;
        u.pm = rb; u.pn = e * ntn + nt; u.e = e; u.r0 = (rb - pb[e]) * 256; return true;
    }
    __device__ __forceinline__ int arow(const Unit& u, int rloc) const {
        if (!GATHER) return u.pm * 256 + rloc;
        const int slot = u.r0 + rloc; return slot < (int)cnt[CNT_IDX(u.e)] ? (ltok[(size_t)u.e * LIST_CAP + slot] >> 1) : 0;
    }
};

constexpr int AT_KROW = 208, AT_KBUF = 64 * AT_KROW, AT_VBUF = 8192, AT_BUF = AT_KBUF + AT_VBUF;
__device__ __forceinline__ s16x4 vtr(const LAS unsigned char* p) { typedef short v4s __attribute__((ext_vector_type(4)));
    return __builtin_bit_cast(s16x4, __builtin_amdgcn_ds_read_tr16_b64_v4i16((LAS v4s*)p)); }
__device__ __forceinline__ void attn_unit(Frame& F, const MKArgs& A, int b, int h, int qb) {
    const bf16* Q = (const bf16*)(F.ws + WS_Q); const bf16* Kn = (const bf16*)(F.ws + WS_K); const bf16* V = (const bf16*)(F.ws + WS_V); const bf16* KR = (const bf16*)(F.ws + WS_KR);
    bf16* MIXED = (bf16*)(F.ws + WS_H); float* SSQA = (float*)(F.ws + WS_SSQA);
    const int tid = F.tid, lane = F.lane, r32 = lane & 31, hi = lane >> 5, wid = F.wave;
    const int t0 = b * SEQ, q0 = qb * 256 + wid * 32;
    bf16x8 qf[6];
    { const bf16* qp = Q + (size_t)(t0 + q0 + r32) * 768 + h * 96 + hi * 8;
#pragma unroll
      for (int s = 0; s < 6; ++s) qf[s] = *(const bf16x8*)(qp + 16 * s); }
    const int NT = 4 * qb + 4, ntw = 4 * qb + (wid >> 1) + 1;
    const int prow = tid >> 3, pch = tid & 7, rrow = tid >> 2, rch = tid & 3;
    const bf16* ksrc = Kn + (size_t)(t0 + prow) * 512 + h * 64 + pch * 8;
    const bf16* vsrc = V + (size_t)(t0 + prow) * 512 + h * 64 + pch * 8;
    const bf16* rsrc = KR + (size_t)(t0 + rrow) * 32 + rch * 8;
    const int kdst = prow * AT_KROW + pch * 16, rdst = rrow * AT_KROW + 128 + rch * 16, vdst = AT_KBUF + (pch >> 2) * 4096 + prow * 64 + (pch & 3) * 16;
    u32x4 kreg, vreg, rreg = (u32x4){0u, 0u, 0u, 0u};
    kreg = *(const u32x4*)ksrc; vreg = *(const u32x4*)vsrc; if (tid < 256) rreg = *(const u32x4*)rsrc;
    __syncthreads();
    *(LAS u32x4*)(F.lds + kdst) = kreg; *(LAS u32x4*)(F.lds + vdst) = vreg; if (tid < 256) *(LAS u32x4*)(F.lds + rdst) = rreg;
    __syncthreads();
    float mrun = -1e30f, lrun = 0.f; f32x16 o0, o1;
#pragma unroll
    for (int r = 0; r < 16; ++r) { o0[r] = 0.f; o1[r] = 0.f; }
    const int koff = r32 * AT_KROW + hi * 16;
    const int voff = AT_KBUF + ((lane >> 4) & 1) * 32 + (lane & 3) * 8 + (4 * hi + ((lane & 15) >> 2)) * 64;
    for (int t = 0; t < NT; ++t) {
        const bool more = (t + 1 < NT);
        if (more) { const size_t adv = (size_t)(t + 1) * 64; kreg = *(const u32x4*)(ksrc + adv * 512); vreg = *(const u32x4*)(vsrc + adv * 512); if (tid < 256) rreg = *(const u32x4*)(rsrc + adv * 32); }
        if (t < ntw) {
            const LAS unsigned char* base = F.lds + (t & 1) * AT_BUF;
            f32x16 p0, p1;
#pragma unroll
            for (int r = 0; r < 16; ++r) { p0[r] = 0.f; p1[r] = 0.f; }
#pragma unroll
            for (int s = 0; s < 6; ++s) { const bf16x8 a0 = *(const LAS bf16x8*)(base + koff + s * 32), a1 = *(const LAS bf16x8*)(base + koff + 32 * AT_KROW + s * 32);
                p0 = __builtin_amdgcn_mfma_f32_32x32x16_bf16(a0, qf[s], p0, 0, 0, 0); p1 = __builtin_amdgcn_mfma_f32_32x32x16_bf16(a1, qf[s], p1, 0, 0, 0); }
            float mx = fmaxf(p0[0], p1[0]);
#pragma unroll
            for (int r = 1; r < 16; ++r) mx = fmaxf(mx, fmaxf(p0[r], p1[r]));
            mx = fmaxf(mx, __shfl_xor(mx, 32));
            const float mnew = fmaxf(mrun, mx), alpha = __builtin_amdgcn_exp2f(mrun - mnew); mrun = mnew;
            float rs = 0.f;
#pragma unroll
            for (int r = 0; r < 16; ++r) { p0[r] = __builtin_amdgcn_exp2f(p0[r] - mnew); p1[r] = __builtin_amdgcn_exp2f(p1[r] - mnew); rs += p0[r] + p1[r]; }
            lrun = lrun * alpha + rs;
#pragma unroll
            for (int r = 0; r < 16; ++r) { o0[r] *= alpha; o1[r] *= alpha; }
            bf16x8 pf[4];
            { u32x4 w;
              w = (u32x4){cvt_pk_bf16(p0[0], p0[1]), cvt_pk_bf16(p0[2], p0[3]), cvt_pk_bf16(p0[4], p0[5]), cvt_pk_bf16(p0[6], p0[7])}; pf[0] = __builtin_bit_cast(bf16x8, w);
              w = (u32x4){cvt_pk_bf16(p0[8], p0[9]), cvt_pk_bf16(p0[10], p0[11]), cvt_pk_bf16(p0[12], p0[13]), cvt_pk_bf16(p0[14], p0[15])}; pf[1] = __builtin_bit_cast(bf16x8, w);
              w = (u32x4){cvt_pk_bf16(p1[0], p1[1]), cvt_pk_bf16(p1[2], p1[3]), cvt_pk_bf16(p1[4], p1[5]), cvt_pk_bf16(p1[6], p1[7])}; pf[2] = __builtin_bit_cast(bf16x8, w);
              w = (u32x4){cvt_pk_bf16(p1[8], p1[9]), cvt_pk_bf16(p1[10], p1[11]), cvt_pk_bf16(p1[12], p1[13]), cvt_pk_bf16(p1[14], p1[15])}; pf[3] = __builtin_bit_cast(bf16x8, w); }
#pragma unroll
            for (int ks = 0; ks < 4; ++ks) {
                const s16x4 l0 = vtr(base + voff + ks * 1024), h0 = vtr(base + voff + ks * 1024 + 512);
                const s16x4 l1 = vtr(base + voff + 4096 + ks * 1024), h1 = vtr(base + voff + 4096 + ks * 1024 + 512);
                const bf16x8 v0 = (bf16x8){l0[0], l0[1], l0[2], l0[3], h0[0], h0[1], h0[2], h0[3]}, v1 = (bf16x8){l1[0], l1[1], l1[2], l1[3], h1[0], h1[1], h1[2], h1[3]};
                o0 = __builtin_amdgcn_mfma_f32_32x32x16_bf16(v0, pf[ks], o0, 0, 0, 0); o1 = __builtin_amdgcn_mfma_f32_32x32x16_bf16(v1, pf[ks], o1, 0, 0, 0);
            }
        }
        if (more) { LAS unsigned char* nb = F.lds + ((t + 1) & 1) * AT_BUF;
            *(LAS u32x4*)(nb + kdst) = kreg; *(LAS u32x4*)(nb + vdst) = vreg; if (tid < 256) *(LAS u32x4*)(nb + rdst) = rreg; }
        __syncthreads();
    }
    const float ltot = lrun + __shfl_xor(lrun, 32), inv = 1.f / ltot;
    float ss = 0.f;
#pragma unroll
    for (int r = 0; r < 16; ++r) { o0[r] *= inv; o1[r] *= inv; ss += o0[r] * o0[r] + o1[r] * o1[r]; }
    ss += __shfl_xor(ss, 32);
    const int trow = t0 + q0 + r32;
    if (hi == 0) SSQA[(size_t)trow * 8 + h] = ss;
    bf16* op = MIXED + (size_t)trow * DM + h * 64 + 4 * hi;
#pragma unroll
    for (int g = 0; g < 4; ++g) {
        *(u32x2*)(op + 8 * g) = (u32x2){cvt_pk_bf16(o0[4 * g], o0[4 * g + 1]), cvt_pk_bf16(o0[4 * g + 2], o0[4 * g + 3])};
        *(u32x2*)(op + 32 + 8 * g) = (u32x2){cvt_pk_bf16(o1[4 * g], o1[4 * g + 1]), cvt_pk_bf16(o1[4 * g + 2], o1[4 * g + 3])};
    }
}
__device__ __forceinline__ void conv_block(Frame& F, const MKArgs& A, int blk) {
    const bf16* Z = (const bf16*)(F.ws + WS_Z); const bf16* BG = (const bf16*)(F.ws + WS_BG); bf16* MIXED = (bf16*)(F.ws + WS_H);
    const float* cw = INP(12); const float* cb = INP(13);
    const int ch = 8 * F.lane; float w0[8], w1[8], w2[8], bb[8];
#pragma unroll
    for (int j = 0; j < 8; ++j) { w0[j] = cw[ch + j]; w1[j] = cw[512 + ch + j]; w2[j] = cw[1024 + ch + j]; bb[j] = cb[ch + j]; }
    const int row0 = blk * 128 + F.wave * 16; const int s0 = row0 % SEQ;
    float zm2[8], zm1[8];
#define ldz(row, o) do { const u32x4 v_ = *(const u32x4*)(Z + (size_t)(row) * 512 + ch); \
        o[0] = bf2f(v_.x & 0xffff); o[1] = bf2f(v_.x >> 16); o[2] = bf2f(v_.y & 0xffff); o[3] = bf2f(v_.y >> 16); o[4] = bf2f(v_.z & 0xffff); o[5] = bf2f(v_.z >> 16); o[6] = bf2f(v_.w & 0xffff); o[7] = bf2f(v_.w >> 16); } while (0)
#pragma unroll
    for (int j = 0; j < 8; ++j) { zm2[j] = 0.f; zm1[j] = 0.f; }
    if (s0 >= 2) { ldz(row0 - 2, zm2); ldz(row0 - 1, zm1); }
    for (int i = 0; i < 16; ++i) { const int row = row0 + i; float zc[8], bgv[8], val[8]; ldz(row, zc);
        { const u32x4 v = *(const u32x4*)(BG + (size_t)row * 512 + ch);
          bgv[0] = bf2f(v.x & 0xffff); bgv[1] = bf2f(v.x >> 16); bgv[2] = bf2f(v.y & 0xffff); bgv[3] = bf2f(v.y >> 16); bgv[4] = bf2f(v.z & 0xffff); bgv[5] = bf2f(v.z >> 16); bgv[6] = bf2f(v.w & 0xffff); bgv[7] = bf2f(v.w >> 16); }
        float ss = 0.f;
#pragma unroll
        for (int j = 0; j < 8; ++j) { val[j] = bgv[j] * (w0[j] * zm2[j] + w1[j] * zm1[j] + w2[j] * zc[j] + bb[j]); ss += val[j] * val[j]; zm2[j] = zm1[j]; zm1[j] = zc[j]; }
        const float r = rsqrtf(wave_sum(ss) * (1.f / 512.f) + RMS_EPS);
        *(u32x4*)(MIXED + (size_t)row * DM + 512 + ch) = (u32x4){pk2(val[0] * r, val[1] * r), pk2(val[2] * r, val[3] * r), pk2(val[4] * r, val[5] * r), pk2(val[6] * r, val[7] * r)};
    }
}
__device__ __forceinline__ void phase4(Frame& F, const MKArgs& A) {
    for (int v = F.vcu; v < 256; v += F.G) {
        const int bh = v >> 1, s = v & 1;
        for (int i = 0; i < 4; ++i) { const int qb = (i == 0) ? s : (i == 1) ? 7 - s : (i == 2) ? 2 + s : 5 - s; attn_unit(F, A, bh >> 3, bh & 7, qb); }
    }
    for (int blk = F.bid; blk < T / 128; blk += F.G) conv_block(F, A, blk);
}

__device__ __forceinline__ void phase6(Frame& F, const MKArgs& A) {
    const float* x1 = A.xo; const float* g = INP(17); const float* mod = (const float*)(F.ws + WS_MOD);
    const float* wrg = INP(18); const float* brg = INP(19); const float* wre = INP(20); const float* bre = INP(21);
    bf16* H2 = (bf16*)(F.ws + WS_H); unsigned* cnt = (unsigned*)(F.ws + WS_CTL) + CW_CNT;
    int* ltok = (int*)(F.ws + WS_LTOK); float* lw = (float*)(F.ws + WS_LW); int* route = (int*)(F.ws + WS_ROUTE);
    LAS float* WR = (LAS float*)F.lds;
    LAS float* Gs = (LAS float*)(F.lds + 147456); LAS float* Ss = Gs + 1024;
    LAS int* rinfo = (LAS int*)(F.lds + 155648); LAS unsigned* lcnt = (LAS unsigned*)(F.lds + 157696); LAS unsigned* lbase = lcnt + 32;
    __syncthreads();
    if (F.tid < 32) lcnt[F.tid] = 0u;
    for (int i = F.tid; i < 1024 * 4; i += NTHR) { const int k = i >> 2, e = i & 3; WR[e * 1024 + k] = wrg[i]; }
    for (int i = F.tid; i < 1024 * 32; i += NTHR) { const int k = i >> 5, e = i & 31; WR[(4 + e) * 1024 + k] = wre[i]; }
    for (int blk = F.bid; blk < T / 128; blk += F.G) {
        const int b = (blk * 128) / SEQ;
        __syncthreads();
        for (int k = F.tid; k < 1024; k += NTHR) { Gs[k] = g[k] * (1.f + mod[b * 6144 + 4096 + k]); Ss[k] = mod[b * 6144 + 3072 + k]; }
        __syncthreads();
        for (int rr = F.wave; rr < 128; rr += NWAVES) {
            const int row = blk * 128 + rr;
            const f32x4* xr = (const f32x4*)(x1 + (size_t)row * DM) + F.lane;
            f32x4 v[4]; float s = 0.f;
#pragma unroll
            for (int j = 0; j < 4; ++j) { v[j] = xr[64 * j]; s += (v[j].x * v[j].x + v[j].y * v[j].y) + (v[j].z * v[j].z + v[j].w * v[j].w); }
            const float r = rsqrtf(wave_sum(s) * (1.f / DM) + RMS_EPS);
            unsigned long long* o8 = (unsigned long long*)(H2 + (size_t)row * DM) + F.lane;
#pragma unroll
            for (int j = 0; j < 4; ++j) { const f32x4 gg = *(const LAS f32x4*)(Gs + 4 * F.lane + 256 * j), ss = *(const LAS f32x4*)(Ss + 4 * F.lane + 256 * j);
                v[j] = v[j] * r * gg + ss;
                o8[64 * j] = (unsigned long long)pk2(v[j].x, v[j].y) | ((unsigned long long)pk2(v[j].z, v[j].w) << 32); }
            float gl[4];
#pragma unroll
            for (int e = 0; e < 4; ++e) { float a = 0.f;
#pragma unroll
                for (int j = 0; j < 4; ++j) { const f32x4 w = *(const LAS f32x4*)(WR + e * 1024 + 4 * F.lane + 256 * j); a += (v[j].x * w.x + v[j].y * w.y) + (v[j].z * w.z + v[j].w * w.w); }
                gl[e] = wave_sum(a) + brg[e]; }
            int gi = 0; float gm = gl[0];
#pragma unroll
            for (int e = 1; e < 4; ++e) if (gl[e] > gm) { gm = gl[e]; gi = e; }
            gi = __builtin_amdgcn_readfirstlane(gi);
            float se = 0.f;
#pragma unroll
            for (int e = 0; e < 4; ++e) se += __expf(gl[e] - gm);
            const float pg = 1.f / se;
            float el[8];
            const LAS float* WE = WR + (4 + gi * 8) * 1024;
#pragma unroll
            for (int e = 0; e < 8; ++e) { float a = 0.f;
#pragma unroll
                for (int j = 0; j < 4; ++j) { const f32x4 w = *(const LAS f32x4*)(WE + e * 1024 + 4 * F.lane + 256 * j); a += (v[j].x * w.x + v[j].y * w.y) + (v[j].z * w.z + v[j].w * w.w); }
                el[e] = wave_sum(a) + bre[gi * 8 + e]; }
            int i0 = 0; float v0 = el[0];
#pragma unroll
            for (int e = 1; e < 8; ++e) if (el[e] > v0) { v0 = el[e]; i0 = e; }
            int i1 = -1; float v1 = -3.0e38f;
#pragma unroll
            for (int e = 0; e < 8; ++e) if (e != i0 && el[e] > v1) { v1 = el[e]; i1 = e; }
            const float e1 = __expf(v1 - v0); const float w0 = pg / (1.f + e1), w1 = pg * e1 / (1.f + e1);
            if (F.lane == 0) {
                const int ex0 = gi * 8 + i0, ex1 = gi * 8 + i1;
                rinfo[rr * 4] = ex0; rinfo[rr * 4 + 1] = ex1; ((LAS float*)rinfo)[rr * 4 + 2] = w0; ((LAS float*)rinfo)[rr * 4 + 3] = w1;
                route[row * 4] = ex0; route[row * 4 + 1] = ex1; ((float*)route)[row * 4 + 2] = w0; ((float*)route)[row * 4 + 3] = w1;
            }
        }
        __syncthreads();
        int e_ = 0, pos_ = 0; const int arow_ = F.tid >> 1, ak_ = F.tid & 1;
        if (F.tid < 256) { e_ = rinfo[arow_ * 4 + ak_]; pos_ = (int)__hip_atomic_fetch_add(lcnt + e_, 1u, __ATOMIC_RELAXED, __HIP_MEMORY_SCOPE_WORKGROUP); }
        __syncthreads();
        if (F.tid < 32) { const unsigned c_ = lcnt[F.tid]; lbase[F.tid] = c_ ? atomicAdd(&cnt[CNT_IDX(F.tid)], c_) : 0u; lcnt[F.tid] = 0u; }
        __syncthreads();
        if (F.tid < 256) { const size_t slot = (size_t)e_ * LIST_CAP + lbase[e_] + pos_;
            ltok[slot] = (blk * 128 + arow_) * 2 + ak_; lw[slot] = ((LAS float*)rinfo)[arow_ * 4 + 2 + ak_]; }
    }
}

__device__ __forceinline__ void phase8(Frame& F, const MKArgs& A) {
    float* xo = A.xo; const float* fg = INP(25); const float* mod = (const float*)(F.ws + WS_MOD); const bf16* Y = (const bf16*)(F.ws + WS_Y);
    for (int blk = F.bid; blk < T / 128; blk += F.G) {
        const int b = (blk * 128) / SEQ; const float* g2 = mod + b * 6144 + 5120;
        f32x4 gv[4], fv[4];
#pragma unroll
        for (int j = 0; j < 4; ++j) { gv[j] = *(const f32x4*)(g2 + 4 * F.lane + 256 * j); fv[j] = *(const f32x4*)(fg + 4 * F.lane + 256 * j); }
        for (int rr = F.wave; rr < 128; rr += NWAVES) {
            const int row = blk * 128 + rr;
            f32x4* xr = (f32x4*)(xo + (size_t)row * DM) + F.lane;
            const u32x2* y0 = (const u32x2*)(Y + (size_t)row * DM) + F.lane; const u32x2* y1 = (const u32x2*)(Y + ((size_t)T + row) * DM) + F.lane;
            f32x4 v[4]; float s = 0.f;
#pragma unroll
            for (int j = 0; j < 4; ++j) { const u32x2 a = y0[64 * j], c = y1[64 * j];
                f32x4 yy; yy.x = bf2f(a.x & 0xffff) + bf2f(c.x & 0xffff); yy.y = bf2f(a.x >> 16) + bf2f(c.x >> 16); yy.z = bf2f(a.y & 0xffff) + bf2f(c.y & 0xffff); yy.w = bf2f(a.y >> 16) + bf2f(c.y >> 16);
                v[j] = xr[64 * j] + gv[j] * yy; s += (v[j].x * v[j].x + v[j].y * v[j].y) + (v[j].z * v[j].z + v[j].w * v[j].w); }
            float r = rsqrtf(wave_sum(s) * (1.f / DM) + RMS_EPS);
#if MK_TIMING
            { const unsigned long long* ts = (const unsigned long long*)(F.ws + WS_CTL) + 1024;
              const float ta = (float)(ts[TP_A + 1] - ts[TP_A]) * 0.01f; r *= 1.f + sqrtf(ta * 1e-7f); }
#endif
#pragma unroll
            for (int j = 0; j < 4; ++j) xr[64 * j] = v[j] * r * fv[j];
#if MK_TIMING
            if (row == 0 && F.lane == 0) { const unsigned long long* ts = (const unsigned long long*)(F.ws + WS_CTL) + 1024;
              const float tb = (float)(ts[TP_B + 1] - ts[TP_B]) * 0.01f; xo[0] += 0.5f + tb * 0.05f; }
#endif
        }
    }
}

constexpr int N_PHASES = 10;
__global__ void __launch_bounds__(NTHR, 2) mk_fwd(MKArgs args) {
    extern __shared__ __attribute__((aligned(16))) unsigned char lds_raw[];
    Frame F; F.lds = (LAS unsigned char*)lds_raw; F.tid = threadIdx.x; F.lane = F.tid & 63; F.wave = __builtin_amdgcn_readfirstlane(F.tid >> 6);
    F.bid = blockIdx.x; F.G = gridDim.x; F.vcu = (F.G % 8 == 0) ? (F.bid % 8) * (F.G / 8) + F.bid / 8 : F.bid; F.ws = args.ws;
    volatile LAS unsigned* MISC = (volatile LAS unsigned*)(F.lds + MISC_OFF);
    for (int u = F.tid; u < 128; u += NTHR) MISC[u] = 0u;
    __syncthreads();
    const int lo = args.ph_lo, hi = args.ph_hi;
    XcdBarrier bar; bar.bar = (unsigned*)(F.ws + WS_CTL) + CW_BAR; bar.x = 0; bar.st = nullptr;
    if (hi - lo > 1) bar = xcd_barrier_post((unsigned*)(F.ws + WS_CTL) + CW_BAR, MISC + 8);
#ifndef PH_MASK
#define PH_MASK 0xFFFF
#endif
#define IN(k) (((PH_MASK >> (k)) & 1) && lo <= (k) && (k) < hi)
#if MK_TIMING
#define STAMP(k) do { if (F.bid == 0 && F.tid == 0) ((unsigned long long*)(F.ws + WS_CTL))[1024 + (k)] = __builtin_amdgcn_s_memrealtime(); } while (0)
#else
#define STAMP(k) do {} while (0)
#endif
#define SEAM(k) do { if ((k) == 8) STAMP(9); if (IN(k) && IN((k) + 1)) xcd_barrier(bar); if ((k) != 8) STAMP((k) + 1); } while (0)
    STAMP(0);
    if (IN(0)) { phase0(F, args); } SEAM(0);
    if (IN(1)) { phase1(F, args); } SEAM(1);
    if (IN(2)) {
        pg8::Gemm g{(const bf16*)(F.ws + WS_H), (const bf16*)(F.ws + WS_WIN), 1024}; pg8::StaticOrder S; S.init(T, 2048, F.G, F.bid);
        EpiP2 E{(bf16*)(F.ws + WS_QC), (bf16*)(F.ws + WS_KVX), (bf16*)(F.ws + WS_Z), (bf16*)(F.ws + WS_BG), (bf16*)(F.ws + WS_KR), (float*)(F.ws + WS_SSQQ), (float*)(F.ws + WS_SSQKV),
                (const float*)(F.ws + WS_ROPE), (const float*)(F.ws + WS_ROPE) + (size_t)T * 16};
        pg8::gemm_phase<EpiP2, pg8::StaticOrder, true>(F.lds, g, S, E);
    } SEAM(2);
    if (IN(3)) {
        { pg8::Gemm g{(const bf16*)(F.ws + WS_QC), (const bf16*)(F.ws + WS_WUQ), 256}; pg8::StaticOrder S; S.init(T, 768, F.G, F.bid);
          EpiQ E{(bf16*)(F.ws + WS_Q), (const float*)(F.ws + WS_SSQQ), (const float*)(F.ws + WS_ROPE), (const float*)(F.ws + WS_ROPE) + (size_t)T * 16};
          pg8::gemm_phase<EpiQ, pg8::StaticOrder, true>(F.lds, g, S, E); }
        { pg8::Gemm g{(const bf16*)(F.ws + WS_KVX), (const bf16*)(F.ws + WS_WUKV), 256}; pg8::StaticOrder S; S.init(T, 1024, F.G, F.G - 1 - F.bid);
          EpiKV E{(bf16*)(F.ws + WS_K), (bf16*)(F.ws + WS_V), (const float*)(F.ws + WS_SSQKV)};
          pg8::gemm_phase<EpiKV, pg8::StaticOrder, true>(F.lds, g, S, E); }
    } SEAM(3);
    if (IN(4)) { phase4(F, args); } SEAM(4);
    if (IN(5)) {
        pg8::Gemm g{(const bf16*)(F.ws + WS_H), (const bf16*)(F.ws + WS_WOUT), 1024}; pg8::StaticOrder S; S.init(T, 1024, F.G, F.bid);
        EpiOut E{args.in[0], (const float*)(F.ws + WS_MOD), args.xo, (const float*)(F.ws + WS_SSQA)};
        pg8::gemm_phase<EpiOut, pg8::StaticOrder, true>(F.lds, g, S, E);
    } SEAM(5);
    if (IN(6)) { phase6(F, args); } SEAM(6);
    if (IN(7) || IN(8)) {
        const unsigned* cnt = (const unsigned*)(F.ws + WS_CTL) + CW_CNT;
        __syncthreads();
        if (F.tid == 0) { int acc = 0; for (int e = 0; e < 32; ++e) { ((volatile LAS int*)MISC)[16 + e] = acc; acc += (int)((__hip_atomic_load(cnt + CNT_IDX(e), __ATOMIC_RELAXED, __HIP_MEMORY_SCOPE_AGENT) + 255u) >> 8); } ((volatile LAS int*)MISC)[16 + 32] = acc; }
        __syncthreads();
    }
    if (IN(7)) {
        const unsigned* cnt = (const unsigned*)(F.ws + WS_CTL) + CW_CNT;
        pg8::Gemm g{(const bf16*)(F.ws + WS_H), (const bf16*)(F.ws + WS_WGU), 1024};
        MoeOrder<true> S{(volatile LAS int*)MISC + 16, 2, F.G, F.bid, cnt, (const int*)(F.ws + WS_LTOK)};
        EpiAct E{(bf16*)(F.ws + WS_ACT)};
        pg8::gemm_phase<EpiAct, MoeOrder<true>, true>(F.lds, g, S, E);
    } SEAM(7);
    if (IN(8)) {
        const unsigned* cnt = (const unsigned*)(F.ws + WS_CTL) + CW_CNT;
        pg8::Gemm g{(const bf16*)(F.ws + WS_ACT), (const bf16*)(F.ws + WS_WD), 256};
        MoeOrder<false> S{(volatile LAS int*)MISC + 16, 4, F.G, F.bid, cnt, (const int*)(F.ws + WS_LTOK)};
        EpiDown E{(bf16*)(F.ws + WS_Y), (const int*)(F.ws + WS_LTOK), (const float*)(F.ws + WS_LW), cnt};
        pg8::gemm_phase<EpiDown, MoeOrder<false>, true>(F.lds, g, S, E);
    } SEAM(8);
    if (IN(9)) { phase8(F, args); }
#undef IN
#undef SEAM
}
#if MK_DEBUG
namespace ck {
__device__ __forceinline__ unsigned hsh(unsigned x) { x ^= x >> 16; x *= 0x7feb352du; x ^= x >> 15; x *= 0x846ca68bu; x ^= x >> 16; return x; }
__device__ __forceinline__ void chk(unsigned* err, int stage, float got, float ref, float atol, float rtol) { if (!(fabsf(got - ref) <= atol + rtol * fabsf(ref))) atomicAdd(&err[stage], 1u); }
__device__ __forceinline__ float bfr(float f) { return bf2f((unsigned short)f2bf(f)); }
__device__ __forceinline__ float dotbf(const bf16* a, const bf16* b, int n) { float s = 0.f; for (int i = 0; i < n; ++i) s += bf2f(a[i]) * bf2f(b[i]); return s; }
#define ERRP ((unsigned*)(ws + WS_CTL) + CW_ERR)
#define SID (blockIdx.x * blockDim.x + threadIdx.x)

__global__ void c0(MKArgs A) { unsigned char* ws = A.ws; unsigned* err = ERRP; const unsigned s = hsh(SID * 7 + 1);
    const float* mod = (const float*)(ws + WS_MOD);
    { const int b = s & 15, n = (s >> 4) % 6144; float r = 0.f; for (int k = 0; k < 1024; ++k) { float cv = A.in[1][b * 1024 + k]; r += cv / (1.f + expf(-cv)) * A.in[3][(size_t)k * 6144 + n]; } r += A.in[4][n];
      chk(err, 0, mod[b * 6144 + n], r, 2e-3f, 2e-3f); }
    { const int n = (s >> 3) & 2047, k = (s >> 14) & 1023; const int sc = win_src(n & ~31); const float r = sc >= 0 ? bfr(A.in[6][(size_t)k * 1952 + sc + (n & 31)]) : 0.f;
      chk(err, 0, bf2f(((const bf16*)(ws + WS_WIN))[(size_t)n * 1024 + k]), r, 1e-6f, 1e-2f); }
    { const int n = (s >> 5) % 768, k = (s >> 15) & 255; const float r = A.in[9][(size_t)k * 768 + n] * A.in[7][k] * QSCALE;
      chk(err, 0, bf2f(((const bf16*)(ws + WS_WUQ))[(size_t)n * 256 + k]), r, 1e-6f, 1e-2f); }
    { const int n = (s >> 6) & 1023, k = (s >> 16) & 255; const float r = k < 128 ? (n < 512 ? A.in[10][(size_t)k * 512 + n] : A.in[11][(size_t)k * 512 + n - 512]) * A.in[8][k] : 0.f;
      chk(err, 0, bf2f(((const bf16*)(ws + WS_WUKV))[(size_t)n * 256 + k]), r, 1e-6f, 1e-2f); }
    { const int n = (s >> 7) & 1023, k = (s >> 17) & 1023; const float r = A.in[16][(size_t)k * 1024 + n] * (k < 512 ? A.in[14][k] : A.in[15][k - 512]);
      chk(err, 0, bf2f(((const bf16*)(ws + WS_WOUT))[(size_t)n * 1024 + k]), r, 1e-6f, 1e-2f); }
    { const int e = s & 31, n = (s >> 5) & 511, k = (s >> 14) & 1023; const int p = n >> 8, j = n & 255;
      const float r = j < 128 ? A.in[22][((size_t)e * 1024 + k) * 256 + 128 * p + j] : A.in[23][((size_t)e * 1024 + k) * 256 + 128 * p + j - 128];
      chk(err, 0, bf2f(((const bf16*)(ws + WS_WGU))[((size_t)e * 512 + n) * 1024 + k]), r, 1e-6f, 1e-2f); }
    { const int e = (s >> 2) & 31, n = (s >> 7) & 1023, k = (s >> 17) & 255; const float r = A.in[24][((size_t)e * 256 + k) * 1024 + n];
      chk(err, 0, bf2f(((const bf16*)(ws + WS_WD))[((size_t)e * 1024 + n) * 256 + k]), r, 1e-6f, 1e-2f); }
    { const int t = (s >> 4) & 32767, i = s & 15; const float ang = (float)((const int*)A.in[2])[t] * (1.0f / powf(10000.0f, (float)(2 * i) / 32.0f));
      const float* cs = (const float*)(ws + WS_ROPE); chk(err, 0, cs[t * 16 + i], cosf(ang), 1e-4f, 0.f); chk(err, 0, cs[(size_t)T * 16 + t * 16 + i], sinf(ang), 1e-4f, 0.f); }
}
__device__ __forceinline__ float row_rms(const float* x) { float s = 0.f; for (int k = 0; k < 1024; ++k) s += x[k] * x[k]; return rsqrtf(s / 1024.f + RMS_EPS); }
__global__ void c1(MKArgs A) { unsigned char* ws = A.ws; unsigned* err = ERRP; const unsigned s = hsh(SID * 5 + 3);
    const int t = s & 32767, k = (s >> 15) & 1023, b = t / SEQ; const float* mod = (const float*)(ws + WS_MOD);
    const float r = row_rms(A.in[0] + (size_t)t * 1024);
    const float ref = A.in[0][(size_t)t * 1024 + k] * r * A.in[5][k] * (1.f + mod[b * 6144 + 1024 + k]) + mod[b * 6144 + k];
    chk(err, 1, bf2f(((const bf16*)(ws + WS_H))[(size_t)t * 1024 + k]), ref, 2e-3f, 1e-2f);
}
__global__ void c2(MKArgs A) { unsigned char* ws = A.ws; unsigned* err = ERRP; const unsigned s = hsh(SID * 3 + 11);
    const bf16* H = (const bf16*)(ws + WS_H); const bf16* W = (const bf16*)(ws + WS_WIN);
    const int t = s & 32767; const bf16* h = H + (size_t)t * 1024;
    const float* cs = (const float*)(ws + WS_ROPE); const float* sn = cs + (size_t)T * 16;
    const int sel = (s >> 15) % 6; const int j = (s >> 18);
    if (sel == 0) { const int c = j & 255; chk(err, 2, bf2f(((const bf16*)(ws + WS_QC))[(size_t)t * 256 + c]), dotbf(h, W + (size_t)c * 1024, 1024), 2e-2f, 2e-2f); }
    else if (sel == 1) { const int c = j & 255; const float r = c < 160 ? dotbf(h, W + (size_t)(256 + c) * 1024, 1024) : 0.f; chk(err, 2, bf2f(((const bf16*)(ws + WS_KVX))[(size_t)t * 256 + c]), r, 2e-2f, 2e-2f); }
    else if (sel == 2) { const int i = j & 15; const float x1 = dotbf(h, W + (size_t)(384 + i) * 1024, 1024), x2 = dotbf(h, W + (size_t)(400 + i) * 1024, 1024); const float c = cs[t * 16 + i], sv = sn[t * 16 + i];
        chk(err, 2, bf2f(((const bf16*)(ws + WS_KR))[(size_t)t * 32 + i]), x1 * c - x2 * sv, 3e-2f, 2e-2f); chk(err, 2, bf2f(((const bf16*)(ws + WS_KR))[(size_t)t * 32 + 16 + i]), x2 * c + x1 * sv, 3e-2f, 2e-2f); }
    else if (sel == 3) { const int ch = j & 511, p = ch >> 7, jj = ch & 127; const float u = dotbf(h, W + (size_t)(512 + 256 * p + jj) * 1024, 1024), c = dotbf(h, W + (size_t)(512 + 256 * p + 128 + jj) * 1024, 1024);
        chk(err, 2, bf2f(((const bf16*)(ws + WS_Z))[(size_t)t * 512 + ch]), u * c, 3e-2f, 3e-2f); }
    else if (sel == 4) { const int ch = j & 511; chk(err, 2, bf2f(((const bf16*)(ws + WS_BG))[(size_t)t * 512 + ch]), dotbf(h, W + (size_t)(1536 + ch) * 1024, 1024), 2e-2f, 2e-2f); }
    else { const bf16* qc = (const bf16*)(ws + WS_QC) + (size_t)t * 256; const bf16* kv = (const bf16*)(ws + WS_KVX) + (size_t)t * 256; float a = 0.f, b = 0.f;
        for (int i = 0; i < 256; ++i) a += bf2f(qc[i]) * bf2f(qc[i]); for (int i = 0; i < 128; ++i) b += bf2f(kv[i]) * bf2f(kv[i]);
        const float* sq = (const float*)(ws + WS_SSQQ) + (size_t)t * 4; const float* sk = (const float*)(ws + WS_SSQKV) + (size_t)t * 4;
        chk(err, 2, sq[0] + sq[1] + sq[2] + sq[3], a, 1e-2f, 2e-2f); chk(err, 2, sk[0] + sk[1] + sk[2] + sk[3], b, 1e-2f, 2e-2f); }
}
__global__ void c3(MKArgs A) { unsigned char* ws = A.ws; unsigned* err = ERRP; const unsigned s = hsh(SID * 13 + 5);
    const int t = s & 32767; const float* cs = (const float*)(ws + WS_ROPE); const float* sn = cs + (size_t)T * 16;
    const bf16* qc = (const bf16*)(ws + WS_QC) + (size_t)t * 256; const bf16* kv = (const bf16*)(ws + WS_KVX) + (size_t)t * 256;
    if ((s >> 15) & 1) { float a = 0.f; for (int i = 0; i < 256; ++i) a += bf2f(qc[i]) * bf2f(qc[i]); const float rq = rsqrtf(a / 256.f + RMS_EPS);
        const int col = (s >> 16) % 768, d = col % 96; const bf16* W = (const bf16*)(ws + WS_WUQ); float ref;
        if (d < 64) ref = dotbf(qc, W + (size_t)col * 256, 256) * rq;
        else { const int i = (d - 64) & 15, c1_ = col - d + 64 + i, c2_ = c1_ + 16; const float x1 = dotbf(qc, W + (size_t)c1_ * 256, 256) * rq, x2 = dotbf(qc, W + (size_t)c2_ * 256, 256) * rq;
            ref = (d - 64) < 16 ? x1 * cs[t * 16 + i] - x2 * sn[t * 16 + i] : x2 * cs[t * 16 + i] + x1 * sn[t * 16 + i]; }
        chk(err, 3, bf2f(((const bf16*)(ws + WS_Q))[(size_t)t * 768 + col]), ref, 2e-2f, 2e-2f);
    } else { float a = 0.f; for (int i = 0; i < 128; ++i) a += bf2f(kv[i]) * bf2f(kv[i]); const float rk = rsqrtf(a / 128.f + RMS_EPS);
        const int col = (s >> 16) & 1023; const float ref = dotbf(kv, (const bf16*)(ws + WS_WUKV) + (size_t)col * 256, 256) * rk;
        const float got = col < 512 ? bf2f(((const bf16*)(ws + WS_K))[(size_t)t * 512 + col]) : bf2f(((const bf16*)(ws + WS_V))[(size_t)t * 512 + col - 512]);
        chk(err, 3, got, ref, 2e-2f, 2e-2f); }
}
__global__ void c4(MKArgs A) { unsigned char* ws = A.ws; unsigned* err = ERRP; const unsigned s = hsh(SID * 17 + 9);
    const bf16* M = (const bf16*)(ws + WS_H);
    const int t = s & 32767, b = t / SEQ, qi = t % SEQ;
    if (SID < 8192) { const int h = (s >> 15) & 7, d = (s >> 18) & 63; const int nk = (qi / 64 + 1) * 64;
        const bf16* q = (const bf16*)(ws + WS_Q) + (size_t)t * 768 + h * 96; float mx = -1e30f, l = 0.f, o = 0.f, ssq = 0.f;
        for (int j = 0; j < nk; ++j) { const size_t tj = (size_t)b * SEQ + j; float sc = dotbf(q, (const bf16*)(ws + WS_K) + tj * 512 + h * 64, 64) + dotbf(q + 64, (const bf16*)(ws + WS_KR) + tj * 32, 32);
            const float mn = fmaxf(mx, sc), al = exp2f(mx - mn), p = exp2f(sc - mn); l = l * al + p; o = o * al + p * bf2f(((const bf16*)(ws + WS_V))[tj * 512 + h * 64 + d]); mx = mn; }
        chk(err, 4, bf2f(M[(size_t)t * 1024 + h * 64 + d]), o / l, 1e-2f, 3e-2f);
        for (int dd = 0; dd < 64; ++dd) { const float v = bf2f(M[(size_t)t * 1024 + h * 64 + dd]); ssq += v * v; }
        chk(err, 4, ((const float*)(ws + WS_SSQA))[(size_t)t * 8 + h], ssq, 1e-3f, 3e-2f);
    } else if (SID < 8192 + 4096) { const bf16* Z = (const bf16*)(ws + WS_Z); const bf16* BG = (const bf16*)(ws + WS_BG); const int chs = (s >> 15) & 511; float ss = 0.f, mine = 0.f;
        for (int ch = 0; ch < 512; ++ch) { float zc = A.in[13][ch];
            for (int w = 0; w < 3; ++w) { const int ts = qi + w - 2; if (ts >= 0) zc += bf2f(Z[(size_t)(t + w - 2) * 512 + ch]) * A.in[12][w * 512 + ch]; }
            const float v = bf2f(BG[(size_t)t * 512 + ch]) * zc; ss += v * v; if (ch == chs) mine = v; }
        chk(err, 4, bf2f(M[(size_t)t * 1024 + 512 + chs]), mine * rsqrtf(ss / 512.f + RMS_EPS), 1e-2f, 2e-2f); }
}
__global__ void c5(MKArgs A) { unsigned char* ws = A.ws; unsigned* err = ERRP; const unsigned s = hsh(SID * 19 + 2);
    const int t = s & 32767, n = (s >> 15) & 1023, b = t / SEQ; const bf16* M = (const bf16*)(ws + WS_H) + (size_t)t * 1024; const bf16* W = (const bf16*)(ws + WS_WOUT) + (size_t)n * 1024;
    const float* sa = (const float*)(ws + WS_SSQA) + (size_t)t * 8; float a = 0.f; for (int i = 0; i < 8; ++i) a += sa[i]; const float ra = rsqrtf(a / 512.f + RMS_EPS);
    const float acc = ra * dotbf(M, W, 512) + dotbf(M + 512, W + 512, 512); const float* mod = (const float*)(ws + WS_MOD);
    chk(err, 5, A.xo[(size_t)t * 1024 + n], A.in[0][(size_t)t * 1024 + n] + mod[b * 6144 + 2048 + n] * acc, 1e-2f, 1e-2f);
}
__global__ void c6(MKArgs A) { unsigned char* ws = A.ws; unsigned* err = ERRP; const unsigned s = hsh(SID * 23 + 7);
    const int t = s & 32767, b = t / SEQ; const float* mod = (const float*)(ws + WS_MOD); const float* x1 = A.xo + (size_t)t * 1024; const float r = row_rms(x1);
    { const int k = (s >> 15) & 1023; const float ref = x1[k] * r * A.in[17][k] * (1.f + mod[b * 6144 + 4096 + k]) + mod[b * 6144 + 3072 + k];
      chk(err, 6, bf2f(((const bf16*)(ws + WS_H))[(size_t)t * 1024 + k]), ref, 2e-3f, 1e-2f); }
    if (SID < 4096) { float gl[4] = {0, 0, 0, 0}, el[32]; for (int e = 0; e < 32; ++e) el[e] = 0.f;
        for (int k = 0; k < 1024; ++k) { const float hv = x1[k] * r * A.in[17][k] * (1.f + mod[b * 6144 + 4096 + k]) + mod[b * 6144 + 3072 + k];
            for (int e = 0; e < 4; ++e) gl[e] += hv * A.in[18][k * 4 + e]; for (int e = 0; e < 32; ++e) el[e] += hv * A.in[20][k * 32 + e]; }
        for (int e = 0; e < 4; ++e) gl[e] += A.in[19][e]; for (int e = 0; e < 32; ++e) el[e] += A.in[21][e];
        int gi = 0; for (int e = 1; e < 4; ++e) if (gl[e] > gl[gi]) gi = e; float g2 = -1e30f; for (int e = 0; e < 4; ++e) if (e != gi) g2 = fmaxf(g2, gl[e]);
        float se = 0.f; for (int e = 0; e < 4; ++e) se += expf(gl[e] - gl[gi]);
        int i0 = 0; for (int e = 1; e < 8; ++e) if (el[gi * 8 + e] > el[gi * 8 + i0]) i0 = e; int i1 = -1; for (int e = 0; e < 8; ++e) if (e != i0 && (i1 < 0 || el[gi * 8 + e] > el[gi * 8 + i1])) i1 = e;
        float v2 = -1e30f; for (int e = 0; e < 8; ++e) if (e != i0 && e != i1) v2 = fmaxf(v2, el[gi * 8 + e]);
        const float v0 = el[gi * 8 + i0], v1 = el[gi * 8 + i1];
        if (gl[gi] - g2 > 1e-3f && v0 - v1 > 1e-3f && v1 - v2 > 1e-3f) { const int* rt = (const int*)(ws + WS_ROUTE) + t * 4; const float e1 = expf(v1 - v0), pg = 1.f / se;
            if (rt[0] != gi * 8 + i0 || rt[1] != gi * 8 + i1) atomicAdd(&err[6], 1u);
            chk(err, 6, ((const float*)rt)[2], pg / (1.f + e1), 1e-3f, 1e-2f); chk(err, 6, ((const float*)rt)[3], pg * e1 / (1.f + e1), 1e-3f, 1e-2f); } }
    { const unsigned* cnt = (const unsigned*)(ws + WS_CTL) + CW_CNT; if (SID == 0) { unsigned tot = 0; for (int e = 0; e < 32; ++e) tot += cnt[CNT_IDX(e)]; if (tot != 65536u) atomicAdd(&err[6], 1u); }
      const int e = (s >> 3) & 31; const unsigned ce_ = cnt[CNT_IDX(e)]; const unsigned slot = (s >> 8) % (ce_ ? ce_ : 1u); if (ce_) { const int tk = ((const int*)(ws + WS_LTOK))[(size_t)e * LIST_CAP + slot];
        const int* rt = (const int*)(ws + WS_ROUTE) + (tk >> 1) * 4; if ((tk >> 1) < 0 || (tk >> 1) >= T || rt[tk & 1] != e) atomicAdd(&err[6], 1u);
        else chk(err, 6, ((const float*)(ws + WS_LW))[(size_t)e * LIST_CAP + slot], ((const float*)rt)[2 + (tk & 1)], 0.f, 0.f); } }
}
__global__ void c7(MKArgs A) { unsigned char* ws = A.ws; unsigned* err = ERRP; const unsigned s = hsh(SID * 29 + 13);
    const unsigned* cnt = (const unsigned*)(ws + WS_CTL) + CW_CNT; const int e = s & 31; if (!cnt[CNT_IDX(e)]) return; const unsigned slot = (s >> 5) % cnt[CNT_IDX(e)];
    int pb = 0; for (int i = 0; i < e; ++i) pb += (cnt[CNT_IDX(i)] + 255) >> 8;
    const int tk = ((const int*)(ws + WS_LTOK))[(size_t)e * LIST_CAP + slot]; const bf16* h2 = (const bf16*)(ws + WS_H) + (size_t)(tk >> 1) * 1024;
    const int j = (s >> 20) & 255, p = j >> 7, jj = j & 127; const bf16* W = (const bf16*)(ws + WS_WGU) + ((size_t)e * 512 + 256 * p + jj) * 1024;
    const float g = dotbf(h2, W, 1024), u = dotbf(h2, W + 128 * 1024, 1024);
    chk(err, 7, bf2f(((const bf16*)(ws + WS_ACT))[((size_t)pb * 256 + slot) * 256 + j]), g / (1.f + expf(-g)) * u, 2e-2f, 3e-2f);
}
__global__ void c8(MKArgs A) { unsigned char* ws = A.ws; unsigned* err = ERRP; const unsigned s = hsh(SID * 31 + 17);
    const unsigned* cnt = (const unsigned*)(ws + WS_CTL) + CW_CNT; const int e = s & 31; if (!cnt[CNT_IDX(e)]) return; const unsigned slot = (s >> 5) % cnt[CNT_IDX(e)];
    int pb = 0; for (int i = 0; i < e; ++i) pb += (cnt[CNT_IDX(i)] + 255) >> 8;
    const int tk = ((const int*)(ws + WS_LTOK))[(size_t)e * LIST_CAP + slot]; const float w = ((const float*)(ws + WS_LW))[(size_t)e * LIST_CAP + slot];
    const int n = (s >> 20) & 1023; const float ref = w * dotbf((const bf16*)(ws + WS_ACT) + ((size_t)pb * 256 + slot) * 256, (const bf16*)(ws + WS_WD) + ((size_t)e * 1024 + n) * 256, 256);
    chk(err, 8, bf2f(((const bf16*)(ws + WS_Y))[((size_t)(tk & 1) * T + (tk >> 1)) * 1024 + n]), ref, 5e-3f, 3e-2f);
}
__global__ void c9(MKArgs A, const float* gold, float* acc2) { float d = 0.f, r = 0.f;
    for (size_t i = SID; i < (size_t)T * 1024; i += (size_t)gridDim.x * blockDim.x) { const float a = A.xo[i], b = gold[i]; d += (a - b) * (a - b); r += b * b; if (!(fabsf(a) < 1e30f)) d += 1e30f; }
    d = wave_sum(d); r = wave_sum(r); if ((threadIdx.x & 63) == 0) { atomicAdd(&acc2[0], d); atomicAdd(&acc2[1], r); }
}
__global__ void report(MKArgs A, float* gold, const float* acc2, int use_mega) { unsigned char* ws = A.ws; const unsigned* err = ERRP;
    int code = 0; for (int i = 0; i < 9; ++i) if (err[i] != 0 && code == 0) code = i + 1;
    if (code == 0 && !(acc2[0] <= 3e-5f * acc2[1])) code = 10;
    const float f = 1.f + 0.03f * code;
    for (size_t i = SID; i < (size_t)T * 1024; i += (size_t)gridDim.x * blockDim.x) gold[i] = (use_mega && code == 0 ? A.xo[i] : gold[i]) * f;
}
}
#endif
extern "C" void kernel_launch(void* const* d_in, const int* in_sizes, int n_in, void* d_out, int out_size, void* d_ws, size_t ws_size, hipStream_t stream) {
    static int grid = 0;
    if (grid == 0) {
        int dev = 0, cus = 0, per_cu = 0;
        if (n_in != 26 || out_size != T * DM || ws_size < 496 * MiB) { fprintf(stderr, "kernel_launch: unexpected problem (n_in %d out %d ws %zu)\n", n_in, out_size, ws_size); grid = -1; return; }
        if (hipGetDevice(&dev) != hipSuccess || hipDeviceGetAttribute(&cus, hipDeviceAttributeMultiprocessorCount, dev) != hipSuccess) { grid = -1; return; }
        if (hipFuncSetAttribute((const void*)mk_fwd, hipFuncAttributeMaxDynamicSharedMemorySize, LDS_BYTES) != hipSuccess) { fprintf(stderr, "kernel_launch: hipFuncSetAttribute failed\n"); grid = -1; return; }
        if (hipOccupancyMaxActiveBlocksPerMultiprocessor(&per_cu, (const void*)mk_fwd, NTHR, LDS_BYTES) != hipSuccess || per_cu < 1) { fprintf(stderr, "kernel_launch: occupancy query says %d\n", per_cu); }
        (void)hipGetLastError();
        grid = cus;
    }
    if (grid < 0) return;
    MKArgs a{};
    for (int i = 0; i < 26; ++i) a.in[i] = (const float*)d_in[i];
    a.ws = (unsigned char*)d_ws;
#if MK_DEBUG
    nv::run(d_in, (float*)d_out, (char*)d_ws, stream);
    (void)hipMemsetAsync(d_ws, 0, ZERO_BYTES, stream);
    a.xo = (float*)((char*)d_ws + WS_X1DBG);
    for (int p = 0; p < N_PHASES; ++p) {
        a.ph_lo = p; a.ph_hi = p + 1;
        hipLaunchKernelGGL(mk_fwd, dim3(grid), dim3(NTHR), LDS_BYTES, stream, a);
        switch (p) {
            case 0: hipLaunchKernelGGL(ck::c0, dim3(64), dim3(256), 0, stream, a); break;
            case 1: hipLaunchKernelGGL(ck::c1, dim3(64), dim3(256), 0, stream, a); break;
            case 2: hipLaunchKernelGGL(ck::c2, dim3(64), dim3(256), 0, stream, a); break;
            case 3: hipLaunchKernelGGL(ck::c3, dim3(64), dim3(256), 0, stream, a); break;
            case 4: hipLaunchKernelGGL(ck::c4, dim3(64), dim3(256), 0, stream, a); break;
            case 5: hipLaunchKernelGGL(ck::c5, dim3(64), dim3(256), 0, stream, a); break;
            case 6: hipLaunchKernelGGL(ck::c6, dim3(64), dim3(256), 0, stream, a); break;
            case 7: hipLaunchKernelGGL(ck::c7, dim3(64), dim3(256), 0, stream, a); break;
            case 8: hipLaunchKernelGGL(ck::c8, dim3(64), dim3(256), 0, stream, a); break;
            default: break;
        }
    }
    float* acc2 = (float*)((char*)d_ws + WS_CTL) + 1024;
    hipLaunchKernelGGL(ck::c9, dim3(1024), dim3(256), 0, stream, a, (const float*)d_out, acc2);
    hipLaunchKernelGGL(ck::report, dim3(1024), dim3(256), 0, stream, a, (float*)d_out, (const float*)acc2, MK_DEBUG_USE_MEGA);
#else
    (void)hipMemsetAsync(d_ws, 0, ZERO_BYTES, stream);
    a.xo = (float*)d_out; a.ph_lo = 0; a.ph_hi = N_PHASES;
    hipLaunchKernelGGL(mk_fwd, dim3(grid), dim3(NTHR), LDS_BYTES, stream, a);
#endif
}
```

```cpp
#include <hip/hip_runtime.h>
#include <cstdio>
#include <cstdint>
#define MK_DEBUG 0
#define MK_TIMING 0
#define GAS __attribute__((address_space(1)))
#define LAS __attribute__((address_space(3)))
typedef unsigned short bf16;
typedef unsigned short bf16_t;
typedef short bf16x8 __attribute__((ext_vector_type(8)));
typedef short s16x4 __attribute__((ext_vector_type(4)));
typedef float f32x4 __attribute__((ext_vector_type(4)));
typedef float f32x2 __attribute__((ext_vector_type(2)));
typedef float f32x16 __attribute__((ext_vector_type(16)));
typedef unsigned u32x4 __attribute__((ext_vector_type(4)));
typedef unsigned u32x2 __attribute__((ext_vector_type(2)));

constexpr int T = 32768, DM = 1024, NB = 16, SEQ = 2048;
constexpr float RMS_EPS = 1e-6f;
constexpr float QSCALE = 0.10206207261596575f * 1.4426950408889634f;
constexpr int NEXP = 32, LIST_CAP = 65536;
constexpr int ACT_ROWS = 65536 + 32 * 256;

constexpr size_t MiB = 1u << 20;
constexpr size_t WS_CTL = 0;
constexpr size_t WS_MOD = 1 * MiB;
constexpr size_t ZERO_BYTES = 2 * MiB;
constexpr size_t WS_ROPE = 2 * MiB;
constexpr size_t WS_WIN = 6 * MiB;
constexpr size_t WS_WUQ = 10 * MiB;
constexpr size_t WS_WUKV = 10 * MiB + 512 * 1024;
constexpr size_t WS_WOUT = 11 * MiB;
constexpr size_t WS_WGU = 13 * MiB;
constexpr size_t WS_WD = 45 * MiB;
constexpr size_t WS_SSQQ = 61 * MiB;
constexpr size_t WS_SSQKV = 61 * MiB + 512 * 1024;
constexpr size_t WS_SSQA = 62 * MiB;
constexpr size_t WS_LTOK = 63 * MiB;
constexpr size_t WS_LW = 71 * MiB;
constexpr size_t WS_ROUTE = 79 * MiB;
constexpr size_t WS_WRT = 79 * MiB + 512 * 1024;
constexpr size_t WS_H = 80 * MiB;
constexpr size_t WS_QC = 144 * MiB;
constexpr size_t WS_KVX = 160 * MiB;
constexpr size_t WS_Z = 176 * MiB;
constexpr size_t WS_BG = 208 * MiB;
constexpr size_t WS_Q = 240 * MiB;
constexpr size_t WS_K = 288 * MiB;
constexpr size_t WS_V = 320 * MiB;
constexpr size_t WS_KR = 352 * MiB;
constexpr size_t WS_ACT = 144 * MiB;
constexpr size_t WS_Y = 180 * MiB;
constexpr size_t WS_X1B = 308 * MiB;
constexpr size_t WS_X1DBG = 372 * MiB;
constexpr size_t WS_END = 500 * MiB;
constexpr int CW_CNT = 8192;
#define CNT_IDX(e) ((e) * 64)
constexpr int CW_ERR = 256;
constexpr int CW_BAR = 4096;

__device__ __forceinline__ unsigned f2bf(float f) { unsigned u = __builtin_bit_cast(unsigned, f); return (u + 0x7fffu + ((u >> 16) & 1u)) >> 16; }
__device__ __forceinline__ unsigned pk2(float lo, float hi) { return f2bf(lo) | (f2bf(hi) << 16); }
__device__ __forceinline__ float bf2f(unsigned short b) { return __builtin_bit_cast(float, (unsigned)b << 16); }
#define DPP_ADD(v, ctrl, rm) v += __builtin_bit_cast(float, __builtin_amdgcn_update_dpp(0, __builtin_bit_cast(int, v), ctrl, rm, 0xF, false))
__device__ __forceinline__ float wave_sum(float v) {
    DPP_ADD(v, 0xB1, 0xF);
    DPP_ADD(v, 0x4E, 0xF);
    DPP_ADD(v, 0x141, 0xF);
    DPP_ADD(v, 0x140, 0xF);
    DPP_ADD(v, 0x142, 0xA);
    DPP_ADD(v, 0x143, 0xC);
    return __builtin_bit_cast(float, __builtin_amdgcn_readlane(__builtin_bit_cast(int, v), 63));
}
__device__ __forceinline__ float silu_f(float a) { return a / (1.f + __expf(-a)); }
#define LDS_WAIT() asm volatile("s_waitcnt lgkmcnt(0)" ::: "memory")
#define VM_WAIT() asm volatile("s_waitcnt vmcnt(0)" ::: "memory")
namespace pg8 {
#define PG8_LAS __attribute__((address_space(3)))
constexpr int BM = 256, BK = 64, HALF = 128, HTB = HALF * BK * 2, STAGE_BYTES = 8 * HTB, NXCD = 8, WGM = 8;
__host__ __device__ __forceinline__ int lds_byte(int r, int c) { const int st = (r >> 4) * 2 + (c >> 5), rr = r & 15, cc = c & 31, ob = rr * 64 + cc * 2; return st * 1024 + (ob ^ (((ob >> 9) & 1) << 5)); }
__host__ __device__ __forceinline__ void stage_rc(int b, int& R, int& C) { const int st = b / 1024, sb = b % 1024, swz = sb ^ (((sb >> 9) & 1) << 5); R = (st >> 1) * 16 + swz / 64; C = (st & 1) * 32 + (swz % 64) / 2; }
__host__ __device__ __forceinline__ int perm32(int rho) { const int n = rho >> 4, i = rho & 15; return 8 * (i >> 2) + 4 * n + (i & 3); }

struct Unit { int pm, pn, e, r0; };
struct Gemm { const bf16_t* A; const bf16_t* Bt; int K; };

struct StaticOrder {
    int nM, nN, nwg, G, c;
    __device__ void init(int M, int N, int G_, int c_) { nM = M / BM; nN = N / BM; nwg = nM * nN; G = G_; c = c_; }
    __device__ bool next(int i, Unit& u) const {
        const long L = (long)i * G + c; if (L >= nwg) return false;
        int wgid = (int)L; { const int q = nwg / NXCD, r = nwg % NXCD, xcd = wgid % NXCD, off = wgid / NXCD; wgid = (xcd < r ? xcd * (q + 1) : r * (q + 1) + (xcd - r) * q) + off; }
        const int nig = WGM * nN, gid = wgid / nig, fm = gid * WGM, gsz = (nM - fm) < WGM ? (nM - fm) : WGM;
        u.pm = fm + ((wgid % nig) % gsz); u.pn = (wgid % nig) / gsz; u.e = 0; u.r0 = 0; return true;
    }
    static constexpr bool GATHER = false;
    __device__ __forceinline__ int arow(const Unit& u, int rloc) const { return u.pm * BM + rloc; }
};

typedef float f32x2_t_ __attribute__((ext_vector_type(2))); typedef __bf16 bf16x2_t_ __attribute__((ext_vector_type(2)));
__device__ __forceinline__ unsigned cvt_pk_bf16(float lo, float hi) { f32x2_t_ v = {lo, hi}; bf16x2_t_ b = __builtin_convertvector(v, bf16x2_t_); return __builtin_bit_cast(unsigned, b); }

template <class Epi, class Sched, bool ALIGN_EPI>
__device__ __forceinline__ void gemm_phase(PG8_LAS unsigned char* lds, const Gemm g, const Sched& S, const Epi& E, const int wid) {
    unsigned z_ = 0u; asm volatile("" : "+v"(z_));
    const int lane = (int)__builtin_amdgcn_mbcnt_hi(~0u, __builtin_amdgcn_mbcnt_lo(~0u, z_)), tid = wid * 64 + lane, wr = wid >> 2, wc = wid & 3, fr = lane & 15, fq = lane >> 4;
    const int K = g.K, nt = K / BK;
    unsigned voffA[2], voffB[2];
#pragma unroll
    for (int i = 0; i < 2; ++i) { int R, C; stage_rc(tid * 16 + i * 8192, R, C); const int Rb = Epi::PERM ? ((R & ~31) + perm32(R & 31)) : R;
        voffA[i] = (unsigned)(R * K + C) * 2u; voffB[i] = (unsigned)(Rb * K + C) * 2u; }
    const size_t kstep = (size_t)(BK * 2);
    const size_t hstep = (size_t)HALF * K * 2;
    const size_t tstep = 2 * hstep;
    const unsigned ldsw = (unsigned)wid * 1024u;
    const int aoff = lds_byte(wr * 64 + fr, fq * 8), boff = lds_byte(wc * 32 + fr, fq * 8);
#define PG8_SA(b, h) (((b) * 2 + (h)) * HTB)
#define PG8_SB(b, h) ((4 + (b) * 2 + (h)) * HTB)
#define PG8_STAGE(bufoff, gbase, voff) do { _Pragma("unroll") for (int _i = 0; _i < 2; ++_i) \
        __builtin_amdgcn_global_load_lds((const unsigned*)((const char*)(gbase) + (voff)[_i]), (PG8_LAS unsigned*)(lds + (bufoff) + ldsw + _i * 8192), 16, 0, 0); } while (0)
#define PG8_STAGE_A(bufoff, h, kb, usenext) do { _Pragma("unroll") for (int _i = 0; _i < 2; ++_i) { const char* _p; \
        if constexpr (Sched::GATHER) _p = (const char*)g.A + (size_t)(kb) + ((usenext) ? nvA[h][_i] : vA[h][_i]); \
        else _p = ((usenext) ? nA : cA) + (size_t)(kb) + (size_t)(h) * hstep + voffA[_i]; \
        __builtin_amdgcn_global_load_lds((const unsigned*)_p, (PG8_LAS unsigned*)(lds + (bufoff) + ldsw + _i * 8192), 16, 0, 0); } } while (0)
#define PG8_LDA(dst, b, h) do { _Pragma("unroll") for (int m = 0; m < 4; ++m) _Pragma("unroll") for (int k = 0; k < 2; ++k) dst[m][k] = *(const PG8_LAS bf16x8*)(lds + PG8_SA(b, h) + aoff + m * 2048 + k * 1024); } while (0)
#define PG8_LDB(dst, b, h) do { _Pragma("unroll") for (int n = 0; n < 2; ++n) _Pragma("unroll") for (int k = 0; k < 2; ++k) dst[n][k] = *(const PG8_LAS bf16x8*)(lds + PG8_SB(b, h) + boff + n * 2048 + k * 1024); } while (0)
#define PG8_MMA(ai, bj, At, Bt) do { __builtin_amdgcn_s_setprio(1); _Pragma("unroll") for (int m = 0; m < 4; ++m) _Pragma("unroll") for (int n = 0; n < 2; ++n) _Pragma("unroll") for (int k = 0; k < 2; ++k) \
        acc[ai][bj][m][n] = __builtin_amdgcn_mfma_f32_16x16x32_bf16(Bt[n][k], At[m][k], acc[ai][bj][m][n], 0, 0, 0); __builtin_amdgcn_s_setprio(0); } while (0)
#define PG8_WAIT_V(n) asm volatile("s_waitcnt vmcnt(" #n ")" ::: "memory")
#define PG8_WAIT_L(n) asm volatile("s_waitcnt lgkmcnt(" #n ")" ::: "memory")
#define PG8_BAR __builtin_amdgcn_s_barrier()
#define PG8_SCHED __builtin_amdgcn_sched_barrier(0)
#define PG8_SETVO(vo, u) do { _Pragma("unroll") for (int _i = 0; _i < 2; ++_i) { int R_, C_; stage_rc(tid * 16 + _i * 8192, R_, C_); \
        _Pragma("unroll") for (int _h = 0; _h < 2; ++_h) vo[_h][_i] = ((unsigned)S.arow(u, _h * HALF + R_) * (unsigned)K + (unsigned)C_) * 2u; } } while (0)
    Unit cur, nxt; int ui = 0;
    if (!S.next(0, cur)) return;
    f32x4 acc[2][2][4][2];
#pragma unroll
    for (int a = 0; a < 2; ++a)
#pragma unroll
        for (int b = 0; b < 2; ++b)
#pragma unroll
            for (int m = 0; m < 4; ++m)
#pragma unroll
                for (int n = 0; n < 2; ++n) acc[a][b][m][n] = (f32x4){0.f, 0.f, 0.f, 0.f};
    bf16x8 At[4][2], B0[2][2], B1[2][2];
    unsigned vA[2][2], nvA[2][2];
    const char* cA = (const char*)g.A; const char* nA = cA;
    if constexpr (Sched::GATHER) { PG8_SETVO(vA, cur); } else { cA = (const char*)g.A + (size_t)S.arow(cur, 0) * K * 2; }
    const char* cB = (const char*)g.Bt + (size_t)cur.pn * tstep;
    PG8_STAGE(PG8_SB(0, 0), cB, voffB); PG8_STAGE(PG8_SB(0, 1), cB + hstep, voffB); PG8_STAGE_A(PG8_SA(0, 0), 0, 0, false); PG8_STAGE_A(PG8_SA(0, 1), 1, 0, false);
    if (wr == 1) PG8_BAR;
    PG8_WAIT_V(2); PG8_BAR;
    PG8_STAGE(PG8_SB(1, 0), cB + kstep, voffB); PG8_STAGE_A(PG8_SA(1, 0), 0, kstep, false); PG8_STAGE(PG8_SB(1, 1), cB + hstep + kstep, voffB);
    PG8_WAIT_V(6); PG8_BAR;
    for (;;) {
        const bool has_next = S.next(ui + 1, nxt);
        if constexpr (Sched::GATHER) {
            if (has_next) { PG8_SETVO(nvA, nxt); } else {
#pragma unroll
                for (int _h = 0; _h < 2; ++_h)
#pragma unroll
                    for (int _i = 0; _i < 2; ++_i) nvA[_h][_i] = vA[_h][_i]; }
        } else { nA = has_next ? (const char*)g.A + (size_t)S.arow(nxt, 0) * K * 2 : cA; }
        const char* nB = has_next ? (const char*)g.Bt + (size_t)nxt.pn * tstep : cB;
#pragma nounroll
        for (int t = 0; t < nt; t += 2) {
            const bool last = (t == nt - 2);
            if constexpr (Epi::HAS_MID) { if (t == Epi::MID_T) E.mid(acc, cur, wr, wc, fr, fq); }
            const size_t k1 = (size_t)(t + 1) * kstep;
            const size_t k2 = last ? 0 : (size_t)(t + 2) * kstep, k3 = k2 + kstep;
            const char* b2 = last ? nB : cB + (size_t)(t + 2) * kstep; const char* b3 = b2 + kstep;
            PG8_LDB(B0, 0, 0); PG8_LDB(B1, 0, 1); PG8_SCHED; PG8_LDA(At, 0, 0); PG8_STAGE_A(PG8_SA(1, 1), 1, k1, false);
            PG8_WAIT_V(8); PG8_WAIT_L(0); PG8_BAR; PG8_MMA(0, 0, At, B0); PG8_MMA(0, 1, At, B1); PG8_BAR; PG8_SCHED;
            PG8_LDA(At, 0, 1); PG8_STAGE(PG8_SB(0, 0), b2, voffB); PG8_STAGE(PG8_SB(0, 1), b2 + hstep, voffB); PG8_STAGE_A(PG8_SA(0, 0), 0, k2, last);
            PG8_WAIT_V(8); PG8_WAIT_L(0); PG8_BAR; PG8_MMA(1, 0, At, B0); PG8_MMA(1, 1, At, B1); PG8_BAR; PG8_SCHED;
            PG8_LDB(B0, 1, 0); PG8_LDB(B1, 1, 1); PG8_SCHED; PG8_LDA(At, 1, 0); PG8_STAGE_A(PG8_SA(0, 1), 1, k2, last);
            PG8_WAIT_V(8); PG8_WAIT_L(0); PG8_BAR; PG8_MMA(0, 0, At, B0); PG8_MMA(0, 1, At, B1); PG8_BAR; PG8_SCHED;
            PG8_LDA(At, 1, 1); PG8_STAGE(PG8_SB(1, 0), b3, voffB); PG8_STAGE(PG8_SB(1, 1), b3 + hstep, voffB); PG8_STAGE_A(PG8_SA(1, 0), 0, k3, last);
            PG8_WAIT_V(8); PG8_WAIT_L(0); PG8_BAR; PG8_MMA(1, 0, At, B0); PG8_MMA(1, 1, At, B1); PG8_BAR; PG8_SCHED;
        }
        if constexpr (ALIGN_EPI) { if (wr == 0) PG8_BAR; }
        E(acc, cur, wr, wc, fr, fq);
        if (!has_next) break;
#pragma unroll
        for (int a = 0; a < 2; ++a)
#pragma unroll
            for (int b = 0; b < 2; ++b)
#pragma unroll
                for (int m = 0; m < 4; ++m)
#pragma unroll
                    for (int n = 0; n < 2; ++n) acc[a][b][m][n] = (f32x4){0.f, 0.f, 0.f, 0.f};
        cur = nxt; cB = nB; cA = nA; ++ui;
        if constexpr (Sched::GATHER) {
#pragma unroll
            for (int _h = 0; _h < 2; ++_h)
#pragma unroll
                for (int _i = 0; _i < 2; ++_i) vA[_h][_i] = nvA[_h][_i]; }
        if constexpr (ALIGN_EPI) { if (wr == 1) PG8_BAR; }
    }
    PG8_WAIT_V(0);
    if constexpr (!ALIGN_EPI) { if (wr == 0) PG8_BAR; }
    PG8_BAR;
#undef PG8_SA
#undef PG8_SB
#undef PG8_STAGE
#undef PG8_STAGE_A
#undef PG8_LDA
#undef PG8_LDB
#undef PG8_MMA
#undef PG8_WAIT_V
#undef PG8_WAIT_L
#undef PG8_BAR
#undef PG8_SCHED
#undef PG8_SETVO
}
}
#define XB_TMO      128
#define XB_XCNT(j)  (256  + 64 * (j))
#define XB_XSUB(j)  (1280 + 64 * (j))
#define XB_XGEN(j)  (2304 + 64 * (j))
#define XB_TOP      3328
#define XB_TOPGEN   3392
#define XCD_BAR_WORDS 3456
#define XB_SPIN_CAP (1u << 22)
__device__ __forceinline__ unsigned xb_ld(unsigned* p)              { return __hip_atomic_load(p, __ATOMIC_RELAXED, __HIP_MEMORY_SCOPE_AGENT); }
__device__ __forceinline__ unsigned xb_add(unsigned* p, unsigned v) { return __hip_atomic_fetch_add(p, v, __ATOMIC_RELAXED, __HIP_MEMORY_SCOPE_AGENT); }
__device__ __forceinline__ unsigned xb_xcc_id() { return (unsigned)__builtin_amdgcn_s_getreg((3 << 11) | 20) & 0xFu; }
#define XB_SPIN(cond, bar) do { unsigned _sp = 0; while (cond) { __builtin_amdgcn_s_sleep(1); \
    if ((++_sp & 255u) == 0u) { if (xb_ld(&(bar)[XB_TMO])) break; if (_sp > XB_SPIN_CAP) { atomicAdd(&(bar)[XB_TMO], 1u); break; } } } } while (0)
struct XcdBarrier { unsigned* bar; unsigned x; volatile LAS unsigned* st; int wave; };
__device__ __forceinline__ bool xb_thread0(int wave) { unsigned z_ = 0u; asm volatile("" : "+v"(z_)); return wave == 0 && __builtin_amdgcn_mbcnt_hi(~0u, __builtin_amdgcn_mbcnt_lo(~0u, z_)) == 0u; }
__device__ __forceinline__ XcdBarrier xcd_barrier_post(unsigned* bar, volatile LAS unsigned* st, int wave) {
    XcdBarrier b; b.bar = bar; b.x = xb_xcc_id(); b.st = st; b.wave = wave;
    if (xb_thread0(wave)) (void)xb_add(&bar[XB_XCNT(b.x)], 1u);
    return b;
}
__device__ __forceinline__ void xcd_barrier_complete(unsigned* bar, unsigned x, unsigned& nloc, unsigned& nx) {
    const unsigned G = gridDim.x * gridDim.y * gridDim.z;
    unsigned sum, cnt, mine, sp = 0u;
    for (;;) {
        sum = 0u; cnt = 0u; mine = 0u;
#pragma unroll
        for (unsigned j = 0; j < 16; ++j) { const unsigned c = xb_ld(&bar[XB_XCNT(j)]); sum += c; cnt += (c > 0u) ? 1u : 0u; mine = (j == x) ? c : mine; }
        if (sum == G) break;
        __builtin_amdgcn_s_sleep(1);
        if ((++sp & 255u) == 0u) { if (xb_ld(&bar[XB_TMO])) break; if (sp > XB_SPIN_CAP) { atomicAdd(&bar[XB_TMO], 1u); break; } }
    }
    nloc = mine > 0u ? mine : 1u; nx = cnt > 0u ? cnt : 1u;
}
__device__ __forceinline__ void xcd_barrier(const XcdBarrier& b) {
    asm volatile("s_waitcnt vmcnt(0)" ::: "memory");
    __syncthreads();
    if (xb_thread0(b.wave)) {
        unsigned* bar = b.bar;
        __builtin_amdgcn_s_waitcnt(0);
        unsigned nloc = b.st[0], nx = b.st[1];
        if (nloc == 0u) { xcd_barrier_complete(bar, b.x, nloc, nx); b.st[0] = nloc; b.st[1] = nx; }
        const unsigned old = xb_add(&bar[XB_XSUB(b.x)], 1u);
        const unsigned gen = old / nloc;
        if (old + 1u == (gen + 1u) * nloc) {
            __builtin_amdgcn_fence(__ATOMIC_RELEASE, "agent");
            asm volatile("s_waitcnt vmcnt(0)" ::: "memory");
            const unsigned og = xb_add(&bar[XB_TOP], 1u);
            const unsigned tg = og / nx;
            if (og + 1u == (tg + 1u) * nx) xb_add(&bar[XB_TOPGEN], 1u);
            else XB_SPIN(xb_ld(&bar[XB_TOPGEN]) == tg, bar);
            __builtin_amdgcn_fence(__ATOMIC_ACQUIRE, "agent");
            xb_add(&bar[XB_XGEN(b.x)], 1u);
            asm volatile("s_waitcnt vmcnt(0)" ::: "memory");
        } else {
            XB_SPIN(xb_ld(&bar[XB_XGEN(b.x)]) == gen, bar);
            __builtin_amdgcn_fence(__ATOMIC_ACQUIRE, "agent");
            asm volatile("s_waitcnt vmcnt(0)" ::: "memory");
        }
    }
    __syncthreads();
}

struct MKArgs { const float* in[26]; float* xo; unsigned char* ws; int ph_lo, ph_hi; };
constexpr int NWAVES = 8, NTHR = 512;
constexpr int LDS_BYTES = 163840;
constexpr int MISC_OFF = 163840 - 512;

struct Frame {
    LAS unsigned char* lds; int tid, lane, wave, bid, G, vcu; unsigned char* ws;
#if MK_TIMING
    unsigned long long acc_bar, acc_max, acc_body;
#endif
};
#define INP(i) (A.in[i])
#define F_REFRESH() do { unsigned z_ = 0u; asm volatile("" : "+v"(z_)); F.lane = (int)__builtin_amdgcn_mbcnt_hi(~0u, __builtin_amdgcn_mbcnt_lo(~0u, z_)); F.tid = F.wave * 64 + F.lane; } while (0)

__device__ __forceinline__ void tr_item(const float* W, int ldw, int scol0, bf16* WT, int ldt, int drow0, int k0, const float* kscale, float mul, LAS float* scr, int lane) {
    if (W) {
        f32x4 v[8];
#pragma unroll
        for (int i = 0; i < 8; ++i) { const int kk = 8 * i + (lane >> 3); v[i] = *(const f32x4*)(W + (size_t)(k0 + kk) * ldw + scol0 + 4 * (lane & 7)); }
#pragma unroll
        for (int i = 0; i < 8; ++i) { const int kk = 8 * i + (lane >> 3); const float sc = (kscale ? kscale[k0 + kk] : 1.f) * mul; LAS float* d = scr + kk * 33 + 4 * (lane & 7);
            d[0] = v[i].x * sc; d[1] = v[i].y * sc; d[2] = v[i].z * sc; d[3] = v[i].w * sc; }
    } else {
#pragma unroll 8
        for (int i = 0; i < 32; ++i) { const int kk = 2 * i + (lane >> 5); scr[kk * 33 + (lane & 31)] = 0.f; }
    }
    LDS_WAIT(); asm volatile("" ::: "memory");
    const int c = lane & 7;
#pragma unroll
    for (int j = 0; j < 4; ++j) { const int n = (lane >> 3) + 8 * j; const LAS float* s = scr + (8 * c) * 33 + n;
        u32x4 o; o.x = pk2(s[0 * 33], s[1 * 33]); o.y = pk2(s[2 * 33], s[3 * 33]); o.z = pk2(s[4 * 33], s[5 * 33]); o.w = pk2(s[6 * 33], s[7 * 33]);
        *(u32x4*)(WT + (size_t)(drow0 + n) * ldt + k0 + 8 * c) = o; }
    LDS_WAIT(); asm volatile("" ::: "memory");
}
__device__ __forceinline__ int win_src(int n0) {
    if (n0 < 256) return n0;
    if (n0 < 384) return 256 + (n0 - 256);
    if (n0 < 416) return 384 + (n0 - 384);
    if (n0 < 512) return -1;
    if (n0 < 1536) { const int p = (n0 - 512) >> 8, j = (n0 - 512) & 255; return j < 128 ? 416 + 128 * p + j : 1440 + 128 * p + (j - 128); }
    return 928 + (n0 - 1536);
}
__device__ __forceinline__ void phase0(Frame& F, const MKArgs& A) {
    F_REFRESH();
    const float* c = INP(1); const int* pos = (const int*)INP(2); const float* w_ada = INP(3); const float* b_ada = INP(4);
    float* mod = (float*)(F.ws + WS_MOD);
    for (int it = F.bid; it < 192; it += F.G) {
        const int cg = it % 96, kh = it / 96, k0 = kh * 512;
        LAS float* cact = (LAS float*)F.lds;
        LAS float* red = (LAS float*)(F.lds + 32768);
        for (int i = F.tid; i < 16 * 512; i += NTHR) { const int b = i >> 9, k = i & 511; cact[i] = silu_f(c[b * DM + k0 + k]); }
        __syncthreads();
        float acc[16];
#pragma unroll
        for (int b = 0; b < 16; ++b) acc[b] = 0.f;
        const int n = cg * 64 + F.lane; const float* wp = w_ada + (size_t)(k0 + F.wave * 64) * 6144 + n;
#pragma unroll 32
        for (int kk = 0; kk < 64; ++kk) { const float wv = wp[(size_t)kk * 6144];
#pragma unroll
            for (int b = 0; b < 16; ++b) acc[b] += cact[b * 512 + F.wave * 64 + kk] * wv; }
#pragma unroll
        for (int b = 0; b < 16; ++b) red[(F.wave * 16 + b) * 64 + F.lane] = acc[b];
        __syncthreads();
        for (int o = F.tid; o < 1024; o += NTHR) { const int b = o >> 6, l = o & 63; float s = 0.f;
#pragma unroll
            for (int w = 0; w < 8; ++w) s += red[(w * 16 + b) * 64 + l];
            if (kh == 0) s += b_ada[cg * 64 + l];
            atomicAdd(&mod[b * 6144 + cg * 64 + l], s); }
        __syncthreads();
    }
    __syncthreads();
    LAS float* scr = (LAS float*)(F.lds + F.wave * 16384);
    const int gw = F.vcu * NWAVES + F.wave, NGW = F.G * NWAVES;
    constexpr int I_WIN = 64 * 16, I_UQ = 24 * 4, I_UKV = 32 * 4, I_OUT = 32 * 16, I_GU = 32 * 16 * 16, I_D = 32 * 32 * 4;
    constexpr int NITEMS = I_WIN + I_UQ + I_UKV + I_OUT + I_GU + I_D;
    for (int it = gw; it < NITEMS; it += NGW) {
        int r = it;
        if (r < I_WIN) { const int kb = r >> 6, nb = r & 63; const int sc = win_src(nb * 32);
            tr_item(sc >= 0 ? INP(6) : nullptr, 1952, sc, (bf16*)(F.ws + WS_WIN), 1024, nb * 32, kb * 64, nullptr, 1.f, scr, F.lane); continue; } r -= I_WIN;
        if (r < I_UQ) { const int nb = r >> 2, kb = r & 3;
            tr_item(INP(9), 768, nb * 32, (bf16*)(F.ws + WS_WUQ), 256, nb * 32, kb * 64, INP(7), QSCALE, scr, F.lane); continue; } r -= I_UQ;
        if (r < I_UKV) { const int nb = r >> 2, kb = r & 3; const float* src = kb < 2 ? (nb < 16 ? INP(10) : INP(11)) : nullptr;
            tr_item(src, 512, (nb & 15) * 32, (bf16*)(F.ws + WS_WUKV), 256, nb * 32, kb * 64, INP(8), 1.f, scr, F.lane); continue; } r -= I_UKV;
        if (r < I_OUT) { const int kb = r >> 5, nb = r & 31; const float* ks = kb < 8 ? INP(14) : INP(15) - 512;
            tr_item(INP(16), 1024, nb * 32, (bf16*)(F.ws + WS_WOUT), 1024, nb * 32, kb * 64, ks, 1.f, scr, F.lane); continue; } r -= I_OUT;
        if (r < I_GU) { const int e = r >> 8, kb = (r >> 4) & 15, nb = r & 15; const int p = nb >> 3, j0 = (nb & 7) * 32;
            const float* src = (j0 < 128 ? INP(22) : INP(23)) + (size_t)e * 1024 * 256; const int sc = 128 * p + (j0 & 127);
            tr_item(src, 256, sc, (bf16*)(F.ws + WS_WGU), 1024, e * 512 + nb * 32, kb * 64, nullptr, 1.f, scr, F.lane); continue; } r -= I_GU;
        { const int e = r >> 7, kb = (r >> 5) & 3, nb = r & 31;
            tr_item(INP(24) + (size_t)e * 256 * 1024, 1024, nb * 32, (bf16*)(F.ws + WS_WD), 256, e * 1024 + nb * 32, kb * 64, nullptr, 1.f, scr, F.lane); }
    }
    { float* wrt = (float*)(F.ws + WS_WRT);
      for (int i = F.bid * NTHR + F.tid; i < 36 * 1024; i += F.G * NTHR) { const int e = i >> 10, k = i & 1023; wrt[i] = e < 4 ? INP(18)[k * 4 + e] : INP(20)[k * 32 + (e - 4)]; } }
    float* cs = (float*)(F.ws + WS_ROPE); float* sn = cs + (size_t)T * 16;
    for (int i = F.bid * NTHR + F.tid; i < T * 16; i += F.G * NTHR) { const int t = i >> 4, j = i & 15;
        const float invf = 1.0f / powf(10000.0f, (float)(2 * j) / 32.0f); const float ang = (float)pos[t] * invf;
        cs[i] = cosf(ang); sn[i] = sinf(ang); }
}

__device__ __forceinline__ void phase1(Frame& F, const MKArgs& A) {
    F_REFRESH();
    const float* x = INP(0); const float* g = INP(5); const float* mod = (const float*)(F.ws + WS_MOD);
    bf16* H = (bf16*)(F.ws + WS_H);
    LAS float* Gs = (LAS float*)F.lds; LAS float* Ss = Gs + 1024;
    for (int blk = F.bid; blk < T / 128; blk += F.G) {
        const int b = (blk * 128) / SEQ;
        __syncthreads();
        for (int k = F.tid; k < 1024; k += NTHR) { Gs[k] = g[k] * (1.f + mod[b * 6144 + 1024 + k]); Ss[k] = mod[b * 6144 + k]; }
        __syncthreads();
        for (int rr = 2 * F.wave; rr < 128; rr += 2 * NWAVES) {
            const int row = blk * 128 + rr;
            const f32x4* xr = (const f32x4*)(x + (size_t)row * DM) + F.lane;
            f32x4 v[2][4]; float s[2] = {0.f, 0.f};
#pragma unroll
            for (int q = 0; q < 2; ++q)
#pragma unroll
                for (int j = 0; j < 4; ++j) v[q][j] = xr[q * 256 + 64 * j];
#pragma unroll
            for (int q = 0; q < 2; ++q)
#pragma unroll
                for (int j = 0; j < 4; ++j) s[q] += (v[q][j].x * v[q][j].x + v[q][j].y * v[q][j].y) + (v[q][j].z * v[q][j].z + v[q][j].w * v[q][j].w);
#pragma unroll
            for (int q = 0; q < 2; ++q) {
                const float r = rsqrtf(wave_sum(s[q]) * (1.f / DM) + RMS_EPS);
                unsigned long long* o8 = (unsigned long long*)(H + (size_t)(row + q) * DM) + F.lane;
#pragma unroll
                for (int j = 0; j < 4; ++j) { const f32x4 gg = *(const LAS f32x4*)(Gs + 4 * F.lane + 256 * j), ss = *(const LAS f32x4*)(Ss + 4 * F.lane + 256 * j);
                    const f32x4 h = v[q][j] * r * gg + ss;
                    o8[64 * j] = (unsigned long long)pk2(h.x, h.y) | ((unsigned long long)pk2(h.z, h.w) << 32); }
            }
        }
    }
}

using pg8::Unit; using pg8::cvt_pk_bf16;
#define PK4(v0, v1) (u32x4){cvt_pk_bf16((v0)[0], (v0)[1]), cvt_pk_bf16((v0)[2], (v0)[3]), cvt_pk_bf16((v1)[0], (v1)[1]), cvt_pk_bf16((v1)[2], (v1)[3])}
__device__ __forceinline__ void rope_group(f32x4& v0, f32x4& v1, const float* cs, const float* sn, int row, int fq) {
    const int i0 = 8 * (fq & 1);
    const f32x4 c0 = *(const f32x4*)(cs + (size_t)row * 16 + i0), c1 = *(const f32x4*)(cs + (size_t)row * 16 + i0 + 4);
    const f32x4 s0 = *(const f32x4*)(sn + (size_t)row * 16 + i0), s1 = *(const f32x4*)(sn + (size_t)row * 16 + i0 + 4);
    const float sg = fq < 2 ? -1.f : 1.f;
#pragma unroll
    for (int e = 0; e < 4; ++e) { const float o0 = __shfl_xor(v0[e], 32), o1 = __shfl_xor(v1[e], 32);
        v0[e] = v0[e] * c0[e] + sg * o0 * s0[e]; v1[e] = v1[e] * c1[e] + sg * o1 * s1[e]; }
}
struct EpiP2 {
    static constexpr bool PERM = true, HAS_MID = false; static constexpr int MID_T = 0;
    bf16* qc; bf16* kvx; bf16* z; bf16* bg; bf16* kr; float* ssqq; float* ssqkv; const float* cs; const float* sn;
    __device__ __forceinline__ void mid(f32x4 (&)[2][2][4][2], const Unit&, int, int, int, int) const {}
    __device__ __forceinline__ void operator()(f32x4 (&acc)[2][2][4][2], const Unit& u, int wr, int wc, int fr, int fq) const {
        const int pn = u.pn, rowb = u.pm * 256 + wr * 64 + fr, cl = wc * 32 + 8 * fq;
        if (pn == 0) {
#pragma unroll
            for (int ai = 0; ai < 2; ++ai)
#pragma unroll
                for (int m = 0; m < 4; ++m) { const int row = rowb + ai * 128 + m * 16; float ss = 0.f;
#pragma unroll
                    for (int bj = 0; bj < 2; ++bj) { const f32x4 v0 = acc[ai][bj][m][0], v1 = acc[ai][bj][m][1];
                        ss += (v0[0] * v0[0] + v0[1] * v0[1]) + (v0[2] * v0[2] + v0[3] * v0[3]) + (v1[0] * v1[0] + v1[1] * v1[1]) + (v1[2] * v1[2] + v1[3] * v1[3]);
                        *(u32x4*)(qc + (size_t)row * 256 + bj * 128 + cl) = PK4(v0, v1); }
                    ss += __shfl_xor(ss, 16); ss += __shfl_xor(ss, 32);
                    if (fq == 0) ssqq[(size_t)row * 4 + wc] = ss; }
        } else if (pn == 1) {
#pragma unroll
            for (int ai = 0; ai < 2; ++ai)
#pragma unroll
                for (int m = 0; m < 4; ++m) { const int row = rowb + ai * 128 + m * 16;
                    f32x4 v0 = acc[ai][0][m][0], v1 = acc[ai][0][m][1];
                    float ss = (v0[0] * v0[0] + v0[1] * v0[1]) + (v0[2] * v0[2] + v0[3] * v0[3]) + (v1[0] * v1[0] + v1[1] * v1[1]) + (v1[2] * v1[2] + v1[3] * v1[3]);
                    *(u32x4*)(kvx + (size_t)row * 256 + cl) = PK4(v0, v1);
                    ss += __shfl_xor(ss, 16); ss += __shfl_xor(ss, 32);
                    if (fq == 0) ssqkv[(size_t)row * 4 + wc] = ss;
                    v0 = acc[ai][1][m][0]; v1 = acc[ai][1][m][1];
                    *(u32x4*)(kvx + (size_t)row * 256 + 128 + cl) = PK4(v0, v1);
                    if (wc == 0) { rope_group(v0, v1, cs, sn, row, fq); *(u32x4*)(kr + (size_t)row * 32 + 8 * fq) = PK4(v0, v1); }
                    asm volatile("" ::: "memory"); }
        } else if (pn < 6) {
            const int p = pn - 2;
#pragma unroll
            for (int ai = 0; ai < 2; ++ai)
#pragma unroll
                for (int m = 0; m < 4; ++m) { const int row = rowb + ai * 128 + m * 16;
                    const f32x4 v0 = acc[ai][0][m][0] * acc[ai][1][m][0], v1 = acc[ai][0][m][1] * acc[ai][1][m][1];
                    *(u32x4*)(z + (size_t)row * 512 + 128 * p + cl) = PK4(v0, v1); }
        } else {
            const int p = pn - 6;
#pragma unroll
            for (int ai = 0; ai < 2; ++ai)
#pragma unroll
                for (int m = 0; m < 4; ++m) { const int row = rowb + ai * 128 + m * 16;
#pragma unroll
                    for (int bj = 0; bj < 2; ++bj) { const f32x4 v0 = acc[ai][bj][m][0], v1 = acc[ai][bj][m][1];
                        *(u32x4*)(bg + (size_t)row * 512 + 256 * p + bj * 128 + cl) = PK4(v0, v1); } }
        }
    }
};
struct EpiQ {
    static constexpr bool PERM = true, HAS_MID = false; static constexpr int MID_T = 0;
    bf16* Q; const float* ssqq; const float* cs; const float* sn;
    __device__ __forceinline__ void mid(f32x4 (&)[2][2][4][2], const Unit&, int, int, int, int) const {}
    __device__ __forceinline__ void operator()(f32x4 (&acc)[2][2][4][2], const Unit& u, int wr, int wc, int fr, int fq) const {
        const int pn = u.pn, rowb = u.pm * 256 + wr * 64 + fr, cl = wc * 32 + 8 * fq;
#pragma unroll
        for (int ai = 0; ai < 2; ++ai)
#pragma unroll
            for (int m = 0; m < 4; ++m) { const int row = rowb + ai * 128 + m * 16;
                const f32x4 sq = *(const f32x4*)(ssqq + (size_t)row * 4);
                const float rq = rsqrtf(((sq[0] + sq[1]) + (sq[2] + sq[3])) * (1.f / 256.f) + RMS_EPS);
#pragma unroll
                for (int bj = 0; bj < 2; ++bj) { const int col32 = 8 * pn + 4 * bj + wc;
                    f32x4 v0 = acc[ai][bj][m][0] * rq, v1 = acc[ai][bj][m][1] * rq;
                    if ((col32 % 3) == 2) rope_group(v0, v1, cs, sn, row, fq);
                    *(u32x4*)(Q + (size_t)row * 768 + 256 * pn + bj * 128 + cl) = PK4(v0, v1); }
                asm volatile("" ::: "memory"); }
    }
};
struct EpiKV {
    static constexpr bool PERM = true, HAS_MID = false; static constexpr int MID_T = 0;
    bf16* Kb; bf16* Vb; const float* ssqkv;
    __device__ __forceinline__ void mid(f32x4 (&)[2][2][4][2], const Unit&, int, int, int, int) const {}
    __device__ __forceinline__ void operator()(f32x4 (&acc)[2][2][4][2], const Unit& u, int wr, int wc, int fr, int fq) const {
        const int pn = u.pn, rowb = u.pm * 256 + wr * 64 + fr, cl = wc * 32 + 8 * fq;
        bf16* dst = (pn < 2 ? Kb : Vb) + 256 * (pn & 1);
#pragma unroll
        for (int ai = 0; ai < 2; ++ai)
#pragma unroll
            for (int m = 0; m < 4; ++m) { const int row = rowb + ai * 128 + m * 16;
                const f32x4 sq = *(const f32x4*)(ssqkv + (size_t)row * 4);
                const float rk = rsqrtf(((sq[0] + sq[1]) + (sq[2] + sq[3])) * (1.f / 128.f) + RMS_EPS);
#pragma unroll
                for (int bj = 0; bj < 2; ++bj) { const f32x4 v0 = acc[ai][bj][m][0] * rk, v1 = acc[ai][bj][m][1] * rk;
                    *(u32x4*)(dst + (size_t)row * 512 + bj * 128 + cl) = PK4(v0, v1); }
                asm volatile("" ::: "memory"); }
    }
};
struct EpiOut {
    static constexpr bool PERM = true, HAS_MID = true; static constexpr int MID_T = 8;
    const float* x; const float* mod; bf16* x1b; const float* ssqa;
    __device__ __forceinline__ void mid(f32x4 (&acc)[2][2][4][2], const Unit& u, int wr, int wc, int fr, int fq) const {
        const int rowb = u.pm * 256 + wr * 64 + fr;
#pragma unroll
        for (int ai = 0; ai < 2; ++ai)
#pragma unroll
            for (int m = 0; m < 4; ++m) { const int row = rowb + ai * 128 + m * 16;
                const f32x4 a = *(const f32x4*)(ssqa + (size_t)row * 8), b = *(const f32x4*)(ssqa + (size_t)row * 8 + 4);
                const float ra = rsqrtf((((a[0] + a[1]) + (a[2] + a[3])) + ((b[0] + b[1]) + (b[2] + b[3]))) * (1.f / 512.f) + RMS_EPS);
#pragma unroll
                for (int bj = 0; bj < 2; ++bj)
#pragma unroll
                    for (int n = 0; n < 2; ++n) acc[ai][bj][m][n] *= ra; }
    }
    __device__ __forceinline__ void operator()(f32x4 (&acc)[2][2][4][2], const Unit& u, int wr, int wc, int fr, int fq) const {
        asm volatile("" : "+v"(fr), "+v"(fq));
        const int rowb = u.pm * 256 + wr * 64 + fr, col0 = u.pn * 256 + wc * 32 + 8 * fq; const int b = (u.pm * 256) / SEQ;
        const float* g1 = mod + b * 6144 + 2048;
        f32x4 gv[2][2];
#pragma unroll
        for (int bj = 0; bj < 2; ++bj)
#pragma unroll
            for (int n = 0; n < 2; ++n) gv[bj][n] = *(const f32x4*)(g1 + col0 + bj * 128 + n * 4);
#pragma unroll
        for (int ai = 0; ai < 2; ++ai) {
            f32x4 xin[4][2][2];
#pragma unroll
            for (int m = 0; m < 4; ++m)
#pragma unroll
                for (int bj = 0; bj < 2; ++bj)
#pragma unroll
                    for (int n = 0; n < 2; ++n) xin[m][bj][n] = *(const f32x4*)(x + (size_t)(rowb + ai * 128 + m * 16) * DM + col0 + bj * 128 + n * 4);
#pragma unroll
            for (int m = 0; m < 4; ++m)
#pragma unroll
                for (int bj = 0; bj < 2; ++bj) { const f32x4 v0 = xin[m][bj][0] + gv[bj][0] * acc[ai][bj][m][0], v1 = xin[m][bj][1] + gv[bj][1] * acc[ai][bj][m][1];
                    *(u32x4*)(x1b + (size_t)(rowb + ai * 128 + m * 16) * DM + col0 + bj * 128) = PK4(v0, v1); }
            asm volatile("" ::: "memory");
        }
    }
};
struct EpiAct {
    static constexpr bool PERM = true, HAS_MID = false; static constexpr int MID_T = 0;
    bf16* act;
    __device__ __forceinline__ void mid(f32x4 (&)[2][2][4][2], const Unit&, int, int, int, int) const {}
    __device__ __forceinline__ void operator()(f32x4 (&acc)[2][2][4][2], const Unit& u, int wr, int wc, int fr, int fq) const {
        const int rowb = u.pm * 256 + wr * 64 + fr, cl = wc * 32 + 8 * fq, p = u.pn & 1;
#pragma unroll
        for (int ai = 0; ai < 2; ++ai)
#pragma unroll
            for (int m = 0; m < 4; ++m) { const int row = rowb + ai * 128 + m * 16; f32x4 v0, v1;
#pragma unroll
                for (int e = 0; e < 4; ++e) { v0[e] = silu_f(acc[ai][0][m][0][e]) * acc[ai][1][m][0][e]; v1[e] = silu_f(acc[ai][0][m][1][e]) * acc[ai][1][m][1][e]; }
                *(u32x4*)(act + (size_t)row * 256 + 128 * p + cl) = PK4(v0, v1); }
    }
};
struct EpiDown {
    static constexpr bool PERM = true, HAS_MID = false; static constexpr int MID_T = 0;
    bf16* Y; const int* ltok; const float* lw; const unsigned* cnt;
    __device__ __forceinline__ void mid(f32x4 (&)[2][2][4][2], const Unit&, int, int, int, int) const {}
    __device__ __forceinline__ void operator()(f32x4 (&acc)[2][2][4][2], const Unit& u, int wr, int wc, int fr, int fq) const {
        const int cl = wc * 32 + 8 * fq, pn = u.pn & 3; const int ce = (int)cnt[CNT_IDX(u.e)];
#pragma unroll
        for (int ai = 0; ai < 2; ++ai)
#pragma unroll
            for (int m = 0; m < 4; ++m) { const int slot = u.r0 + ai * 128 + wr * 64 + m * 16 + fr;
                if (slot < ce) { const int tk = ltok[(size_t)u.e * LIST_CAP + slot]; const float w = lw[(size_t)u.e * LIST_CAP + slot];
                    bf16* dst = Y + ((size_t)(tk & 1) * T + (tk >> 1)) * DM + 256 * pn + cl;
#pragma unroll
                    for (int bj = 0; bj < 2; ++bj) { const f32x4 v0 = acc[ai][bj][m][0] * w, v1 = acc[ai][bj][m][1] * w; *(u32x4*)(dst + bj * 128) = PK4(v0, v1); } }
                asm volatile("" ::: "memory"); }
    }
};
template <bool GATHER_> struct MoeOrder {
    static constexpr bool GATHER = GATHER_;
    volatile LAS int* pb; int ntn, G, c; const unsigned* cnt; const int* ltok;
    __device__ __forceinline__ bool next(int i, Unit& u) const {
        const int L = i * G + c; const int total = pb[32] * ntn; if (L >= total) return false;
        const int rb = L / ntn, nt = L - rb * ntn; int e = 0;
        for (int j = 1; j < 32; ++j) e = (pb[j] <= rb) ? j : e;
        u.pm = rb; u.pn = e * ntn + nt; u.e = e; u.r0 = (rb - pb[e]) * 256; return true;
    }
    __device__ __forceinline__ int arow(const Unit& u, int rloc) const {
        if (!GATHER) return u.pm * 256 + rloc;
        const int slot = u.r0 + rloc; return slot < (int)cnt[CNT_IDX(u.e)] ? (ltok[(size_t)u.e * LIST_CAP + slot] >> 1) : 0;
    }
};

constexpr int AT_KROW = 208, AT_KBUF = 64 * AT_KROW, AT_VBUF = 8192, AT_BUF = AT_KBUF + AT_VBUF;
__device__ __forceinline__ void glds16_asm(const void* gsrc, unsigned lds_dst) { unsigned keep;
    asm volatile("s_mov_b32 %0, m0\n\ts_mov_b32 m0, %2\n\ts_nop 0\n\tglobal_load_lds_dwordx4 %1, off\n\ts_mov_b32 m0, %0" : "=&s"(keep) : "v"(gsrc), "s"(lds_dst) : "memory"); }
__device__ __forceinline__ float max3f(float a, float b, float c) { float r; asm("v_max3_f32 %0, %1, %2, %3" : "=v"(r) : "v"(a), "v"(b), "v"(c)); return r; }
__device__ __forceinline__ float max2f(float a, float b) { float r; asm("v_max_f32_e32 %0, %1, %2" : "=v"(r) : "v"(a), "v"(b)); return r; }
__device__ __forceinline__ s16x4 vtr(const LAS unsigned char* p) { typedef short v4s __attribute__((ext_vector_type(4)));
    return __builtin_bit_cast(s16x4, __builtin_amdgcn_ds_read_tr16_b64_v4i16((LAS v4s*)p)); }
__device__ __forceinline__ void attn_unit(Frame& F, const MKArgs& A, int b, int h, int qb) {
    const bf16* Q = (const bf16*)(F.ws + WS_Q); const bf16* Kn = (const bf16*)(F.ws + WS_K); const bf16* V = (const bf16*)(F.ws + WS_V); const bf16* KR = (const bf16*)(F.ws + WS_KR);
    bf16* MIXED = (bf16*)(F.ws + WS_H); float* SSQA = (float*)(F.ws + WS_SSQA);
    const int tid = F.tid, lane = F.lane, r32 = lane & 31, hi = lane >> 5, wid = F.wave;
    const int t0 = b * SEQ, q0 = qb * 256 + wid * 32;
    bf16x8 qf[6];
    { const bf16* qp = Q + (size_t)(t0 + q0 + r32) * 768 + h * 96 + hi * 8;
#pragma unroll
      for (int s = 0; s < 6; ++s) qf[s] = *(const bf16x8*)(qp + 16 * s); }
    const int NT = 4 * qb + 4, ntw = 4 * qb + (wid >> 1) + 1;
    const int prow = tid >> 3, pch = tid & 7, rrow = tid >> 2, rch = tid & 3;
    const bf16* ksrc = Kn + (size_t)(t0 + prow) * 512 + h * 64 + pch * 8;
    const bf16* vsrc = V + (size_t)(t0 + prow) * 512 + h * 64 + pch * 8;
    const bf16* rsrc = KR + (size_t)(t0 + rrow) * 32 + rch * 8;
    const int kdst = prow * AT_KROW + pch * 16, rdst = rrow * AT_KROW + 128 + rch * 16, vdst = AT_KBUF + (pch >> 2) * 4096 + prow * 64 + (pch & 3) * 16;
    u32x4 kreg, vreg, rreg = (u32x4){0u, 0u, 0u, 0u};
    kreg = *(const u32x4*)ksrc; vreg = *(const u32x4*)vsrc; if (tid < 256) rreg = *(const u32x4*)rsrc;
    __syncthreads();
    *(LAS u32x4*)(F.lds + kdst) = kreg; *(LAS u32x4*)(F.lds + vdst) = vreg; if (tid < 256) *(LAS u32x4*)(F.lds + rdst) = rreg;
    __syncthreads();
    float mrun = -1e30f, lrun = 0.f; f32x16 o0, o1;
#pragma unroll
    for (int r = 0; r < 16; ++r) { o0[r] = 0.f; o1[r] = 0.f; }
    const int koff = r32 * AT_KROW + hi * 16;
    const int voff = AT_KBUF + ((lane >> 4) & 1) * 32 + (lane & 3) * 8 + (4 * hi + ((lane & 15) >> 2)) * 64;
    for (int t = 0; t < NT; ++t) {
        const bool more = (t + 1 < NT);
        if (more) { const size_t adv = (size_t)(t + 1) * 64; kreg = *(const u32x4*)(ksrc + adv * 512); vreg = *(const u32x4*)(vsrc + adv * 512); if (tid < 256) rreg = *(const u32x4*)(rsrc + adv * 32); }
        if (t < ntw) {
            const LAS unsigned char* base = F.lds + (t & 1) * AT_BUF;
            f32x16 p0, p1;
#pragma unroll
            for (int r = 0; r < 16; ++r) { p0[r] = 0.f; p1[r] = 0.f; }
#pragma unroll
            for (int s = 0; s < 6; ++s) { const bf16x8 a0 = *(const LAS bf16x8*)(base + koff + s * 32), a1 = *(const LAS bf16x8*)(base + koff + 32 * AT_KROW + s * 32);
                p0 = __builtin_amdgcn_mfma_f32_32x32x16_bf16(a0, qf[s], p0, 0, 0, 0); p1 = __builtin_amdgcn_mfma_f32_32x32x16_bf16(a1, qf[s], p1, 0, 0, 0); }
            float mx = fmaxf(p0[0], p1[0]);
#pragma unroll
            for (int r = 1; r < 16; ++r) mx = fmaxf(mx, fmaxf(p0[r], p1[r]));
            mx = fmaxf(mx, __shfl_xor(mx, 32));
            const float mnew = fmaxf(mrun, mx), alpha = __builtin_amdgcn_exp2f(mrun - mnew); mrun = mnew;
            float rs = 0.f;
#pragma unroll
            for (int r = 0; r < 16; ++r) { p0[r] = __builtin_amdgcn_exp2f(p0[r] - mnew); p1[r] = __builtin_amdgcn_exp2f(p1[r] - mnew); rs += p0[r] + p1[r]; }
            lrun = lrun * alpha + rs;
#pragma unroll
            for (int r = 0; r < 16; ++r) { o0[r] *= alpha; o1[r] *= alpha; }
            bf16x8 pf[4];
            { u32x4 w;
              w = (u32x4){cvt_pk_bf16(p0[0], p0[1]), cvt_pk_bf16(p0[2], p0[3]), cvt_pk_bf16(p0[4], p0[5]), cvt_pk_bf16(p0[6], p0[7])}; pf[0] = __builtin_bit_cast(bf16x8, w);
              w = (u32x4){cvt_pk_bf16(p0[8], p0[9]), cvt_pk_bf16(p0[10], p0[11]), cvt_pk_bf16(p0[12], p0[13]), cvt_pk_bf16(p0[14], p0[15])}; pf[1] = __builtin_bit_cast(bf16x8, w);
              w = (u32x4){cvt_pk_bf16(p1[0], p1[1]), cvt_pk_bf16(p1[2], p1[3]), cvt_pk_bf16(p1[4], p1[5]), cvt_pk_bf16(p1[6], p1[7])}; pf[2] = __builtin_bit_cast(bf16x8, w);
              w = (u32x4){cvt_pk_bf16(p1[8], p1[9]), cvt_pk_bf16(p1[10], p1[11]), cvt_pk_bf16(p1[12], p1[13]), cvt_pk_bf16(p1[14], p1[15])}; pf[3] = __builtin_bit_cast(bf16x8, w); }
#pragma unroll
            for (int ks = 0; ks < 4; ++ks) {
                const s16x4 l0 = vtr(base + voff + ks * 1024), h0 = vtr(base + voff + ks * 1024 + 512);
                const s16x4 l1 = vtr(base + voff + 4096 + ks * 1024), h1 = vtr(base + voff + 4096 + ks * 1024 + 512);
                const bf16x8 v0 = (bf16x8){l0[0], l0[1], l0[2], l0[3], h0[0], h0[1], h0[2], h0[3]}, v1 = (bf16x8){l1[0], l1[1], l1[2], l1[3], h1[0], h1[1], h1[2], h1[3]};
                o0 = __builtin_amdgcn_mfma_f32_32x32x16_bf16(v0, pf[ks], o0, 0, 0, 0); o1 = __builtin_amdgcn_mfma_f32_32x32x16_bf16(v1, pf[ks], o1, 0, 0, 0);
            }
        }
        if (more) { LAS unsigned char* nb = F.lds + ((t + 1) & 1) * AT_BUF;
            *(LAS u32x4*)(nb + kdst) = kreg; *(LAS u32x4*)(nb + vdst) = vreg; if (tid < 256) *(LAS u32x4*)(nb + rdst) = rreg; }
        __syncthreads();
    }
    const float ltot = lrun + __shfl_xor(lrun, 32), inv = 1.f / ltot;
    float ss = 0.f;
#pragma unroll
    for (int r = 0; r < 16; ++r) { o0[r] *= inv; o1[r] *= inv; ss += o0[r] * o0[r] + o1[r] * o1[r]; }
    ss += __shfl_xor(ss, 32);
    const int trow = t0 + q0 + r32;
    if (hi == 0) SSQA[(size_t)trow * 8 + h] = ss;
    bf16* op = MIXED + (size_t)trow * DM + h * 64 + 4 * hi;
#pragma unroll
    for (int g = 0; g < 4; ++g) {
        *(u32x2*)(op + 8 * g) = (u32x2){cvt_pk_bf16(o0[4 * g], o0[4 * g + 1]), cvt_pk_bf16(o0[4 * g + 2], o0[4 * g + 3])};
        *(u32x2*)(op + 32 + 8 * g) = (u32x2){cvt_pk_bf16(o1[4 * g], o1[4 * g + 1]), cvt_pk_bf16(o1[4 * g + 2], o1[4 * g + 3])};
    }
}
__device__ __forceinline__ void conv_block(Frame& F, const MKArgs& A, int blk) {
    const bf16* Z = (const bf16*)(F.ws + WS_Z); const bf16* BG = (const bf16*)(F.ws + WS_BG); bf16* MIXED = (bf16*)(F.ws + WS_H);
    const float* cw = INP(12); const float* cb = INP(13);
    int lane_ = F.lane; asm volatile("" : "+v"(lane_));
    const int ch = 8 * lane_; float w0[8], w1[8], w2[8], bb[8];
#pragma unroll
    for (int j = 0; j < 8; ++j) { w0[j] = cw[ch + j]; w1[j] = cw[512 + ch + j]; w2[j] = cw[1024 + ch + j]; bb[j] = cb[ch + j]; }
    const int row0 = blk * 128 + F.wave * 16; const int s0 = row0 % SEQ;
    float zm2[8], zm1[8];
#define ldz(row, o) do { const u32x4 v_ = *(const u32x4*)(Z + (size_t)(row) * 512 + ch); \
        o[0] = bf2f(v_.x & 0xffff); o[1] = bf2f(v_.x >> 16); o[2] = bf2f(v_.y & 0xffff); o[3] = bf2f(v_.y >> 16); o[4] = bf2f(v_.z & 0xffff); o[5] = bf2f(v_.z >> 16); o[6] = bf2f(v_.w & 0xffff); o[7] = bf2f(v_.w >> 16); } while (0)
#pragma unroll
    for (int j = 0; j < 8; ++j) { zm2[j] = 0.f; zm1[j] = 0.f; }
    if (s0 >= 2) { ldz(row0 - 2, zm2); ldz(row0 - 1, zm1); }
    for (int i0 = 0; i0 < 16; i0 += 4) {
        u32x4 zr[4], br[4];
#pragma unroll
        for (int j = 0; j < 4; ++j) { zr[j] = *(const u32x4*)(Z + (size_t)(row0 + i0 + j) * 512 + ch); br[j] = *(const u32x4*)(BG + (size_t)(row0 + i0 + j) * 512 + ch); }
#pragma unroll
        for (int j = 0; j < 4; ++j) { const int row = row0 + i0 + j; float zc[8], bgv[8], val[8];
            { const u32x4 v = zr[j]; zc[0] = bf2f(v.x & 0xffff); zc[1] = bf2f(v.x >> 16); zc[2] = bf2f(v.y & 0xffff); zc[3] = bf2f(v.y >> 16); zc[4] = bf2f(v.z & 0xffff); zc[5] = bf2f(v.z >> 16); zc[6] = bf2f(v.w & 0xffff); zc[7] = bf2f(v.w >> 16); }
            { const u32x4 v = br[j]; bgv[0] = bf2f(v.x & 0xffff); bgv[1] = bf2f(v.x >> 16); bgv[2] = bf2f(v.y & 0xffff); bgv[3] = bf2f(v.y >> 16); bgv[4] = bf2f(v.z & 0xffff); bgv[5] = bf2f(v.z >> 16); bgv[6] = bf2f(v.w & 0xffff); bgv[7] = bf2f(v.w >> 16); }
            float ss = 0.f;
#pragma unroll
            for (int jj = 0; jj < 8; ++jj) { val[jj] = bgv[jj] * (w0[jj] * zm2[jj] + w1[jj] * zm1[jj] + w2[jj] * zc[jj] + bb[jj]); ss += val[jj] * val[jj]; zm2[jj] = zm1[jj]; zm1[jj] = zc[jj]; }
            const float r = rsqrtf(wave_sum(ss) * (1.f / 512.f) + RMS_EPS);
            *(u32x4*)(MIXED + (size_t)row * DM + 512 + ch) = (u32x4){pk2(val[0] * r, val[1] * r), pk2(val[2] * r, val[3] * r), pk2(val[4] * r, val[5] * r), pk2(val[6] * r, val[7] * r)};
        }
    }
}
#if MK_TIMING
#define PSTAMP(k) do { if (F.bid == 0 && xb_thread0(F.wave)) ((unsigned long long*)(F.ws + WS_CTL))[1024 + (k)] = __builtin_amdgcn_s_memrealtime(); } while (0)
#else
#define PSTAMP(k) do {} while (0)
#endif
__device__ __forceinline__ void phase4(Frame& F, const MKArgs& A) {
    F_REFRESH();
    for (int v = F.vcu; v < 256; v += F.G) {
        const int bh = v >> 1, s = v & 1;
        for (int i = 0; i < 4; ++i) { const int qb = (i == 0) ? s : (i == 1) ? 7 - s : (i == 2) ? 2 + s : 5 - s; attn_unit(F, A, bh >> 3, bh & 7, qb); }
    }
    PSTAMP(12);
    for (int blk = F.bid; blk < T / 128; blk += F.G) conv_block(F, A, blk);
    PSTAMP(13);
}

__device__ __forceinline__ void phase6(Frame& F, const MKArgs& A) {
    F_REFRESH();
    const bf16* X1B = (const bf16*)(F.ws + WS_X1B); const float* g = INP(17); const float* mod = (const float*)(F.ws + WS_MOD);
    const float* brg = INP(19); const float* bre = INP(21);
    bf16* H2 = (bf16*)(F.ws + WS_H); unsigned* cnt = (unsigned*)(F.ws + WS_CTL) + CW_CNT;
    int* ltok = (int*)(F.ws + WS_LTOK); float* lw = (float*)(F.ws + WS_LW); int* route = (int*)(F.ws + WS_ROUTE);
    LAS float* WR = (LAS float*)F.lds;
    LAS float* Gs = (LAS float*)(F.lds + 147456); LAS float* Ss = Gs + 1024;
    LAS int* rinfo = (LAS int*)(F.lds + 155648); LAS unsigned* lcnt = (LAS unsigned*)(F.lds + 157696); LAS unsigned* lbase = lcnt + 32;
    __syncthreads();
    if (F.tid < 32) lcnt[F.tid] = 0u;
    { const f32x4* wrt = (const f32x4*)(F.ws + WS_WRT);
      for (int i = F.tid; i < 36 * 256; i += NTHR) *(LAS f32x4*)(WR + 4 * i) = wrt[i]; }
    for (int blk = F.bid; blk < T / 128; blk += F.G) {
        const int b = (blk * 128) / SEQ;
        __syncthreads();
        for (int k = F.tid; k < 1024; k += NTHR) { Gs[k] = g[k] * (1.f + mod[b * 6144 + 4096 + k]); Ss[k] = mod[b * 6144 + 3072 + k]; }
        __syncthreads();
        for (int rr = F.wave; rr < 128; rr += NWAVES) {
            const int row = blk * 128 + rr;
            const u32x4* xr = (const u32x4*)(X1B + (size_t)row * DM) + F.lane;
            float v[2][8]; float s = 0.f;
#pragma unroll
            for (int j = 0; j < 2; ++j) { const u32x4 w = xr[64 * j];
                v[j][0] = bf2f(w.x & 0xffff); v[j][1] = bf2f(w.x >> 16); v[j][2] = bf2f(w.y & 0xffff); v[j][3] = bf2f(w.y >> 16); v[j][4] = bf2f(w.z & 0xffff); v[j][5] = bf2f(w.z >> 16); v[j][6] = bf2f(w.w & 0xffff); v[j][7] = bf2f(w.w >> 16);
#pragma unroll
                for (int i = 0; i < 8; ++i) s += v[j][i] * v[j][i]; }
            const float r = rsqrtf(wave_sum(s) * (1.f / DM) + RMS_EPS);
            u32x4* o16 = (u32x4*)(H2 + (size_t)row * DM) + F.lane;
#pragma unroll
            for (int j = 0; j < 2; ++j) {
#pragma unroll
                for (int q = 0; q < 2; ++q) { const f32x4 gg = *(const LAS f32x4*)(Gs + 8 * F.lane + 512 * j + 4 * q), ss = *(const LAS f32x4*)(Ss + 8 * F.lane + 512 * j + 4 * q);
#pragma unroll
                    for (int i = 0; i < 4; ++i) v[j][4 * q + i] = v[j][4 * q + i] * r * gg[i] + ss[i]; }
                o16[64 * j] = (u32x4){pk2(v[j][0], v[j][1]), pk2(v[j][2], v[j][3]), pk2(v[j][4], v[j][5]), pk2(v[j][6], v[j][7])}; }
#define P6_DOT(WP) ({ float a_ = 0.f; _Pragma("unroll") for (int j = 0; j < 2; ++j) _Pragma("unroll") for (int q = 0; q < 2; ++q) { const f32x4 w_ = *(const LAS f32x4*)((WP) + 8 * F.lane + 512 * j + 4 * q); \
                a_ += (v[j][4 * q] * w_[0] + v[j][4 * q + 1] * w_[1]) + (v[j][4 * q + 2] * w_[2] + v[j][4 * q + 3] * w_[3]); } a_; })
            float gl[4];
#pragma unroll
            for (int e = 0; e < 4; ++e) gl[e] = wave_sum(P6_DOT(WR + e * 1024)) + brg[e];
            int gi = 0; float gm = gl[0];
#pragma unroll
            for (int e = 1; e < 4; ++e) if (gl[e] > gm) { gm = gl[e]; gi = e; }
            gi = __builtin_amdgcn_readfirstlane(gi);
            float se = 0.f;
#pragma unroll
            for (int e = 0; e < 4; ++e) se += __expf(gl[e] - gm);
            const float pg = 1.f / se;
            float el[8];
            const LAS float* WE = WR + (4 + gi * 8) * 1024;
#pragma unroll
            for (int e = 0; e < 8; ++e) el[e] = wave_sum(P6_DOT(WE + e * 1024)) + bre[gi * 8 + e];
#undef P6_DOT
            int i0 = 0; float v0 = el[0];
#pragma unroll
            for (int e = 1; e < 8; ++e) if (el[e] > v0) { v0 = el[e]; i0 = e; }
            int i1 = -1; float v1 = -3.0e38f;
#pragma unroll
            for (int e = 0; e < 8; ++e) if (e != i0 && el[e] > v1) { v1 = el[e]; i1 = e; }
            const float e1 = __expf(v1 - v0); const float w0 = pg / (1.f + e1), w1 = pg * e1 / (1.f + e1);
            if (F.lane == 0) {
                const int ex0 = gi * 8 + i0, ex1 = gi * 8 + i1;
                rinfo[rr * 4] = ex0; rinfo[rr * 4 + 1] = ex1; ((LAS float*)rinfo)[rr * 4 + 2] = w0; ((LAS float*)rinfo)[rr * 4 + 3] = w1;
                route[row * 4] = ex0; route[row * 4 + 1] = ex1; ((float*)route)[row * 4 + 2] = w0; ((float*)route)[row * 4 + 3] = w1;
            }
        }
        __syncthreads();
        int e_ = 0, pos_ = 0; const int arow_ = F.tid >> 1, ak_ = F.tid & 1;
        if (F.tid < 256) { e_ = rinfo[arow_ * 4 + ak_]; pos_ = (int)__hip_atomic_fetch_add(lcnt + e_, 1u, __ATOMIC_RELAXED, __HIP_MEMORY_SCOPE_WORKGROUP); }
        __syncthreads();
        if (F.tid < 32) { const unsigned c_ = lcnt[F.tid]; lbase[F.tid] = c_ ? atomicAdd(&cnt[CNT_IDX(F.tid)], c_) : 0u; lcnt[F.tid] = 0u; }
        __syncthreads();
        if (F.tid < 256) { const size_t slot = (size_t)e_ * LIST_CAP + lbase[e_] + pos_;
            ltok[slot] = (blk * 128 + arow_) * 2 + ak_; lw[slot] = ((LAS float*)rinfo)[arow_ * 4 + 2 + ak_]; }
    }
}

__device__ __forceinline__ void phase8(Frame& F, const MKArgs& A) {
    F_REFRESH();
    float* xo = A.xo; const float* fg = INP(25); const float* mod = (const float*)(F.ws + WS_MOD); const bf16* Y = (const bf16*)(F.ws + WS_Y); const bf16* X1B = (const bf16*)(F.ws + WS_X1B);
#define UNPK8(dst, SRC_) do { const u32x4 t_ = (SRC_); dst[0] = bf2f(t_[0] & 0xffff); dst[1] = bf2f(t_[0] >> 16); dst[2] = bf2f(t_[1] & 0xffff); dst[3] = bf2f(t_[1] >> 16); dst[4] = bf2f(t_[2] & 0xffff); dst[5] = bf2f(t_[2] >> 16); dst[6] = bf2f(t_[3] & 0xffff); dst[7] = bf2f(t_[3] >> 16); } while (0)
    for (int blk = F.bid; blk < T / 128; blk += F.G) {
        const int b = (blk * 128) / SEQ; const float* g2 = mod + b * 6144 + 5120;
        float gv[2][8], fv[2][8];
#pragma unroll
        for (int j = 0; j < 2; ++j)
#pragma unroll
            for (int q = 0; q < 2; ++q) { const f32x4 a = *(const f32x4*)(g2 + 8 * F.lane + 512 * j + 4 * q), c = *(const f32x4*)(fg + 8 * F.lane + 512 * j + 4 * q);
#pragma unroll
                for (int i = 0; i < 4; ++i) { gv[j][4 * q + i] = a[i]; fv[j][4 * q + i] = c[i]; } }
        for (int rr = 2 * F.wave; rr < 128; rr += 2 * NWAVES) {
            const int row = blk * 128 + rr;
            u32x4 xw[2][2], ya[2][2], yb[2][2];
#pragma unroll
            for (int q = 0; q < 2; ++q)
#pragma unroll
                for (int j = 0; j < 2; ++j) { xw[q][j] = ((const u32x4*)(X1B + (size_t)(row + q) * DM))[F.lane + 64 * j]; ya[q][j] = ((const u32x4*)(Y + (size_t)(row + q) * DM))[F.lane + 64 * j]; yb[q][j] = ((const u32x4*)(Y + ((size_t)T + row + q) * DM))[F.lane + 64 * j]; }
#pragma unroll
            for (int q = 0; q < 2; ++q) {
                float v[2][8]; float s = 0.f;
#pragma unroll
                for (int j = 0; j < 2; ++j) { float xx[8], y0[8], y1[8]; UNPK8(xx, xw[q][j]); UNPK8(y0, ya[q][j]); UNPK8(y1, yb[q][j]);
#pragma unroll
                    for (int i = 0; i < 8; ++i) { v[j][i] = xx[i] + gv[j][i] * (y0[i] + y1[i]); s += v[j][i] * v[j][i]; } }
                float r = rsqrtf(wave_sum(s) * (1.f / DM) + RMS_EPS);
#if MK_TIMING
                { const unsigned long long* ts = (const unsigned long long*)(F.ws + WS_CTL) + 1024;
                  const float ta = (float)(ts[TPA_T1] - ts[TPA_T0]) * 0.01f; r *= 1.f + sqrtf(ta * 1e-7f); }
#endif
                float* orow = xo + (size_t)(row + q) * DM + 8 * F.lane;
#pragma unroll
                for (int j = 0; j < 2; ++j) {
                    *(f32x4*)(orow + 512 * j) = (f32x4){v[j][0] * r * fv[j][0], v[j][1] * r * fv[j][1], v[j][2] * r * fv[j][2], v[j][3] * r * fv[j][3]};
                    *(f32x4*)(orow + 512 * j + 4) = (f32x4){v[j][4] * r * fv[j][4], v[j][5] * r * fv[j][5], v[j][6] * r * fv[j][6], v[j][7] * r * fv[j][7]}; }
#if MK_TIMING
                if (row + q == 0 && F.lane == 0) { const unsigned long long* ts = (const unsigned long long*)(F.ws + WS_CTL) + 1024;
                  const float tb = (float)(ts[TPB_T1] - ts[TPB_T0]) * 0.01f; asm volatile("s_waitcnt vmcnt(0)" ::: "memory"); xo[0] += 0.5f + tb * 0.05f; }
#endif
            }
        }
    }
#undef UNPK8
}

constexpr int N_PHASES = 10;
__global__ void __launch_bounds__(NTHR, 2) mk_fwd(MKArgs args) {
    extern __shared__ __attribute__((aligned(16))) unsigned char lds_raw[];
    Frame F; F.lds = (LAS unsigned char*)lds_raw; F.wave = __builtin_amdgcn_readfirstlane(threadIdx.x >> 6); F_REFRESH();
#if MK_TIMING
    F.acc_bar = 0; F.acc_max = 0; F.acc_body = 0;
#endif
    F.bid = blockIdx.x; F.G = gridDim.x; F.vcu = (F.G % 8 == 0) ? (F.bid % 8) * (F.G / 8) + F.bid / 8 : F.bid; F.ws = args.ws;
    volatile LAS unsigned* MISC = (volatile LAS unsigned*)(F.lds + MISC_OFF);
    if (F.tid < 128) MISC[F.tid] = 0u;
    __syncthreads();
    const int lo = args.ph_lo, hi = args.ph_hi;
    XcdBarrier bar; bar.bar = (unsigned*)(F.ws + WS_CTL) + CW_BAR; bar.x = 0; bar.st = nullptr; bar.wave = F.wave;
    if (hi - lo > 1) bar = xcd_barrier_post((unsigned*)(F.ws + WS_CTL) + CW_BAR, MISC + 8, F.wave);
#ifndef PH_MASK
#define PH_MASK 0xFFFF
#endif
#define IN(k) (((PH_MASK >> (k)) & 1) && lo <= (k) && (k) < hi)
#if MK_TIMING
#define STAMP(k) do { if (F.bid == 0 && xb_thread0(F.wave)) ((unsigned long long*)(F.ws + WS_CTL))[1024 + (k)] = __builtin_amdgcn_s_memrealtime(); } while (0)
#else
#define STAMP(k) do {} while (0)
#endif
#define SEAM(k) do { if ((k) == 8) STAMP(9); if (IN(k) && IN((k) + 1)) xcd_barrier(bar); if ((k) != 8) STAMP((k) + 1); } while (0)
    STAMP(0);
    if (IN(0)) { phase0(F, args); } SEAM(0);
    if (IN(1)) { phase1(F, args); } SEAM(1);
    if (IN(2)) {
        pg8::Gemm g{(const bf16*)(F.ws + WS_H), (const bf16*)(F.ws + WS_WIN), 1024}; pg8::StaticOrder S; S.init(T, 2048, F.G, F.bid);
        EpiP2 E{(bf16*)(F.ws + WS_QC), (bf16*)(F.ws + WS_KVX), (bf16*)(F.ws + WS_Z), (bf16*)(F.ws + WS_BG), (bf16*)(F.ws + WS_KR), (float*)(F.ws + WS_SSQQ), (float*)(F.ws + WS_SSQKV),
                (const float*)(F.ws + WS_ROPE), (const float*)(F.ws + WS_ROPE) + (size_t)T * 16};
        pg8::gemm_phase<EpiP2, pg8::StaticOrder, true>(F.lds, g, S, E, F.wave);
    } SEAM(2);
    if (IN(3)) {
        { pg8::Gemm g{(const bf16*)(F.ws + WS_QC), (const bf16*)(F.ws + WS_WUQ), 256}; pg8::StaticOrder S; S.init(T, 768, F.G, F.bid);
          EpiQ E{(bf16*)(F.ws + WS_Q), (const float*)(F.ws + WS_SSQQ), (const float*)(F.ws + WS_ROPE), (const float*)(F.ws + WS_ROPE) + (size_t)T * 16};
          pg8::gemm_phase<EpiQ, pg8::StaticOrder, true>(F.lds, g, S, E, F.wave); }
        { pg8::Gemm g{(const bf16*)(F.ws + WS_KVX), (const bf16*)(F.ws + WS_WUKV), 256}; pg8::StaticOrder S; S.init(T, 1024, F.G, F.G - 1 - F.bid);
          EpiKV E{(bf16*)(F.ws + WS_K), (bf16*)(F.ws + WS_V), (const float*)(F.ws + WS_SSQKV)};
          pg8::gemm_phase<EpiKV, pg8::StaticOrder, true>(F.lds, g, S, E, F.wave); }
    } SEAM(3);
    if (IN(4)) { phase4(F, args); } SEAM(4);
    if (IN(5)) {
        pg8::Gemm g{(const bf16*)(F.ws + WS_H), (const bf16*)(F.ws + WS_WOUT), 1024}; pg8::StaticOrder S; S.init(T, 1024, F.G, F.bid);
        EpiOut E{args.in[0], (const float*)(F.ws + WS_MOD), (bf16*)(F.ws + WS_X1B), (const float*)(F.ws + WS_SSQA)};
        pg8::gemm_phase<EpiOut, pg8::StaticOrder, true>(F.lds, g, S, E, F.wave);
    } SEAM(5);
    if (IN(6)) { phase6(F, args); } SEAM(6);
    if (IN(7) || IN(8)) {
        const unsigned* cnt = (const unsigned*)(F.ws + WS_CTL) + CW_CNT;
        __syncthreads();
        if (xb_thread0(F.wave)) { int acc = 0; for (int e = 0; e < 32; ++e) { ((volatile LAS int*)MISC)[16 + e] = acc; acc += (int)((__hip_atomic_load(cnt + CNT_IDX(e), __ATOMIC_RELAXED, __HIP_MEMORY_SCOPE_AGENT) + 255u) >> 8); } ((volatile LAS int*)MISC)[16 + 32] = acc; }
        __syncthreads();
    }
    if (IN(7)) {
        const unsigned* cnt = (const unsigned*)(F.ws + WS_CTL) + CW_CNT;
        pg8::Gemm g{(const bf16*)(F.ws + WS_H), (const bf16*)(F.ws + WS_WGU), 1024};
        MoeOrder<true> S{(volatile LAS int*)MISC + 16, 2, F.G, F.bid, cnt, (const int*)(F.ws + WS_LTOK)};
        EpiAct E{(bf16*)(F.ws + WS_ACT)};
        pg8::gemm_phase<EpiAct, MoeOrder<true>, true>(F.lds, g, S, E, F.wave);
    } SEAM(7);
    if (IN(8)) {
        const unsigned* cnt = (const unsigned*)(F.ws + WS_CTL) + CW_CNT;
        pg8::Gemm g{(const bf16*)(F.ws + WS_ACT), (const bf16*)(F.ws + WS_WD), 256};
        MoeOrder<false> S{(volatile LAS int*)MISC + 16, 4, F.G, F.bid, cnt, (const int*)(F.ws + WS_LTOK)};
        EpiDown E{(bf16*)(F.ws + WS_Y), (const int*)(F.ws + WS_LTOK), (const float*)(F.ws + WS_LW), cnt};
        pg8::gemm_phase<EpiDown, MoeOrder<false>, true>(F.lds, g, S, E, F.wave);
    } SEAM(8);
    if (IN(9)) { phase8(F, args); }
#undef IN
#undef SEAM
}
#if MK_DEBUG
namespace ck {
__device__ __forceinline__ unsigned hsh(unsigned x) { x ^= x >> 16; x *= 0x7feb352du; x ^= x >> 15; x *= 0x846ca68bu; x ^= x >> 16; return x; }
__device__ __forceinline__ void chk(unsigned* err, int stage, float got, float ref, float atol, float rtol) { if (!(fabsf(got - ref) <= atol + rtol * fabsf(ref))) atomicAdd(&err[stage], 1u); }
__device__ __forceinline__ float bfr(float f) { return bf2f((unsigned short)f2bf(f)); }
__device__ __forceinline__ float dotbf(const bf16* a, const bf16* b, int n) { float s = 0.f; for (int i = 0; i < n; ++i) s += bf2f(a[i]) * bf2f(b[i]); return s; }
#define ERRP ((unsigned*)(ws + WS_CTL) + CW_ERR)
#define SID (blockIdx.x * blockDim.x + threadIdx.x)

__global__ void c0(MKArgs A) { unsigned char* ws = A.ws; unsigned* err = ERRP; const unsigned s = hsh(SID * 7 + 1);
    const float* mod = (const float*)(ws + WS_MOD);
    { const int b = s & 15, n = (s >> 4) % 6144; float r = 0.f; for (int k = 0; k < 1024; ++k) { float cv = A.in[1][b * 1024 + k]; r += cv / (1.f + expf(-cv)) * A.in[3][(size_t)k * 6144 + n]; } r += A.in[4][n];
      chk(err, 0, mod[b * 6144 + n], r, 2e-3f, 2e-3f); }
    { const int n = (s >> 3) & 2047, k = (s >> 14) & 1023; const int sc = win_src(n & ~31); const float r = sc >= 0 ? bfr(A.in[6][(size_t)k * 1952 + sc + (n & 31)]) : 0.f;
      chk(err, 0, bf2f(((const bf16*)(ws + WS_WIN))[(size_t)n * 1024 + k]), r, 1e-6f, 1e-2f); }
    { const int n = (s >> 5) % 768, k = (s >> 15) & 255; const float r = A.in[9][(size_t)k * 768 + n] * A.in[7][k] * QSCALE;
      chk(err, 0, bf2f(((const bf16*)(ws + WS_WUQ))[(size_t)n * 256 + k]), r, 1e-6f, 1e-2f); }
    { const int n = (s >> 6) & 1023, k = (s >> 16) & 255; const float r = k < 128 ? (n < 512 ? A.in[10][(size_t)k * 512 + n] : A.in[11][(size_t)k * 512 + n - 512]) * A.in[8][k] : 0.f;
      chk(err, 0, bf2f(((const bf16*)(ws + WS_WUKV))[(size_t)n * 256 + k]), r, 1e-6f, 1e-2f); }
    { const int n = (s >> 7) & 1023, k = (s >> 17) & 1023; const float r = A.in[16][(size_t)k * 1024 + n] * (k < 512 ? A.in[14][k] : A.in[15][k - 512]);
      chk(err, 0, bf2f(((const bf16*)(ws + WS_WOUT))[(size_t)n * 1024 + k]), r, 1e-6f, 1e-2f); }
    { const int e = s & 31, n = (s >> 5) & 511, k = (s >> 14) & 1023; const int p = n >> 8, j = n & 255;
      const float r = j < 128 ? A.in[22][((size_t)e * 1024 + k) * 256 + 128 * p + j] : A.in[23][((size_t)e * 1024 + k) * 256 + 128 * p + j - 128];
      chk(err, 0, bf2f(((const bf16*)(ws + WS_WGU))[((size_t)e * 512 + n) * 1024 + k]), r, 1e-6f, 1e-2f); }
    { const int e = (s >> 2) & 31, n = (s >> 7) & 1023, k = (s >> 17) & 255; const float r = A.in[24][((size_t)e * 256 + k) * 1024 + n];
      chk(err, 0, bf2f(((const bf16*)(ws + WS_WD))[((size_t)e * 1024 + n) * 256 + k]), r, 1e-6f, 1e-2f); }
    { const int t = (s >> 4) & 32767, i = s & 15; const float ang = (float)((const int*)A.in[2])[t] * (1.0f / powf(10000.0f, (float)(2 * i) / 32.0f));
      const float* cs = (const float*)(ws + WS_ROPE); chk(err, 0, cs[t * 16 + i], cosf(ang), 1e-4f, 0.f); chk(err, 0, cs[(size_t)T * 16 + t * 16 + i], sinf(ang), 1e-4f, 0.f); }
}
__device__ __forceinline__ float row_rms(const float* x) { float s = 0.f; for (int k = 0; k < 1024; ++k) s += x[k] * x[k]; return rsqrtf(s / 1024.f + RMS_EPS); }
__global__ void c1(MKArgs A) { unsigned char* ws = A.ws; unsigned* err = ERRP; const unsigned s = hsh(SID * 5 + 3);
    const int t = s & 32767, k = (s >> 15) & 1023, b = t / SEQ; const float* mod = (const float*)(ws + WS_MOD);
    const float r = row_rms(A.in[0] + (size_t)t * 1024);
    const float ref = A.in[0][(size_t)t * 1024 + k] * r * A.in[5][k] * (1.f + mod[b * 6144 + 1024 + k]) + mod[b * 6144 + k];
    chk(err, 1, bf2f(((const bf16*)(ws + WS_H))[(size_t)t * 1024 + k]), ref, 2e-3f, 1e-2f);
}
__global__ void c2(MKArgs A) { unsigned char* ws = A.ws; unsigned* err = ERRP; const unsigned s = hsh(SID * 3 + 11);
    const bf16* H = (const bf16*)(ws + WS_H); const bf16* W = (const bf16*)(ws + WS_WIN);
    const int t = s & 32767; const bf16* h = H + (size_t)t * 1024;
    const float* cs = (const float*)(ws + WS_ROPE); const float* sn = cs + (size_t)T * 16;
    const int sel = (s >> 15) % 6; const int j = (s >> 18);
    if (sel == 0) { const int c = j & 255; chk(err, 2, bf2f(((const bf16*)(ws + WS_QC))[(size_t)t * 256 + c]), dotbf(h, W + (size_t)c * 1024, 1024), 2e-2f, 2e-2f); }
    else if (sel == 1) { const int c = j & 255; const float r = c < 160 ? dotbf(h, W + (size_t)(256 + c) * 1024, 1024) : 0.f; chk(err, 2, bf2f(((const bf16*)(ws + WS_KVX))[(size_t)t * 256 + c]), r, 2e-2f, 2e-2f); }
    else if (sel == 2) { const int i = j & 15; const float x1 = dotbf(h, W + (size_t)(384 + i) * 1024, 1024), x2 = dotbf(h, W + (size_t)(400 + i) * 1024, 1024); const float c = cs[t * 16 + i], sv = sn[t * 16 + i];
        chk(err, 2, bf2f(((const bf16*)(ws + WS_KR))[(size_t)t * 32 + i]), x1 * c - x2 * sv, 3e-2f, 2e-2f); chk(err, 2, bf2f(((const bf16*)(ws + WS_KR))[(size_t)t * 32 + 16 + i]), x2 * c + x1 * sv, 3e-2f, 2e-2f); }
    else if (sel == 3) { const int ch = j & 511, p = ch >> 7, jj = ch & 127; const float u = dotbf(h, W + (size_t)(512 + 256 * p + jj) * 1024, 1024), c = dotbf(h, W + (size_t)(512 + 256 * p + 128 + jj) * 1024, 1024);
        chk(err, 2, bf2f(((const bf16*)(ws + WS_Z))[(size_t)t * 512 + ch]), u * c, 3e-2f, 3e-2f); }
    else if (sel == 4) { const int ch = j & 511; chk(err, 2, bf2f(((const bf16*)(ws + WS_BG))[(size_t)t * 512 + ch]), dotbf(h, W + (size_t)(1536 + ch) * 1024, 1024), 2e-2f, 2e-2f); }
    else { const bf16* qc = (const bf16*)(ws + WS_QC) + (size_t)t * 256; const bf16* kv = (const bf16*)(ws + WS_KVX) + (size_t)t * 256; float a = 0.f, b = 0.f;
        for (int i = 0; i < 256; ++i) a += bf2f(qc[i]) * bf2f(qc[i]); for (int i = 0; i < 128; ++i) b += bf2f(kv[i]) * bf2f(kv[i]);
        const float* sq = (const float*)(ws + WS_SSQQ) + (size_t)t * 4; const float* sk = (const float*)(ws + WS_SSQKV) + (size_t)t * 4;
        chk(err, 2, sq[0] + sq[1] + sq[2] + sq[3], a, 1e-2f, 2e-2f); chk(err, 2, sk[0] + sk[1] + sk[2] + sk[3], b, 1e-2f, 2e-2f); }
}
__global__ void c3(MKArgs A) { unsigned char* ws = A.ws; unsigned* err = ERRP; const unsigned s = hsh(SID * 13 + 5);
    const int t = s & 32767; const float* cs = (const float*)(ws + WS_ROPE); const float* sn = cs + (size_t)T * 16;
    const bf16* qc = (const bf16*)(ws + WS_QC) + (size_t)t * 256; const bf16* kv = (const bf16*)(ws + WS_KVX) + (size_t)t * 256;
    if ((s >> 15) & 1) { float a = 0.f; for (int i = 0; i < 256; ++i) a += bf2f(qc[i]) * bf2f(qc[i]); const float rq = rsqrtf(a / 256.f + RMS_EPS);
        const int col = (s >> 16) % 768, d = col % 96; const bf16* W = (const bf16*)(ws + WS_WUQ); float ref;
        if (d < 64) ref = dotbf(qc, W + (size_t)col * 256, 256) * rq;
        else { const int i = (d - 64) & 15, c1_ = col - d + 64 + i, c2_ = c1_ + 16; const float x1 = dotbf(qc, W + (size_t)c1_ * 256, 256) * rq, x2 = dotbf(qc, W + (size_t)c2_ * 256, 256) * rq;
            ref = (d - 64) < 16 ? x1 * cs[t * 16 + i] - x2 * sn[t * 16 + i] : x2 * cs[t * 16 + i] + x1 * sn[t * 16 + i]; }
        chk(err, 3, bf2f(((const bf16*)(ws + WS_Q))[(size_t)t * 768 + col]), ref, 2e-2f, 2e-2f);
    } else { float a = 0.f; for (int i = 0; i < 128; ++i) a += bf2f(kv[i]) * bf2f(kv[i]); const float rk = rsqrtf(a / 128.f + RMS_EPS);
        const int col = (s >> 16) & 1023; const float ref = dotbf(kv, (const bf16*)(ws + WS_WUKV) + (size_t)col * 256, 256) * rk;
        const float got = col < 512 ? bf2f(((const bf16*)(ws + WS_K))[(size_t)t * 512 + col]) : bf2f(((const bf16*)(ws + WS_V))[(size_t)t * 512 + col - 512]);
        chk(err, 3, got, ref, 2e-2f, 2e-2f); }
}
__global__ void c4(MKArgs A) { unsigned char* ws = A.ws; unsigned* err = ERRP; const unsigned s = hsh(SID * 17 + 9);
    const bf16* M = (const bf16*)(ws + WS_H);
    const int t = s & 32767, b = t / SEQ, qi = t % SEQ;
    if (SID < 8192) { const int h = (s >> 15) & 7, d = (s >> 18) & 63; const int nk = (qi / 64 + 1) * 64;
        const bf16* q = (const bf16*)(ws + WS_Q) + (size_t)t * 768 + h * 96; float mx = -1e30f, l = 0.f, o = 0.f, ssq = 0.f;
        for (int j = 0; j < nk; ++j) { const size_t tj = (size_t)b * SEQ + j; float sc = dotbf(q, (const bf16*)(ws + WS_K) + tj * 512 + h * 64, 64) + dotbf(q + 64, (const bf16*)(ws + WS_KR) + tj * 32, 32);
            const float mn = fmaxf(mx, sc), al = exp2f(mx - mn), p = exp2f(sc - mn); l = l * al + p; o = o * al + p * bf2f(((const bf16*)(ws + WS_V))[tj * 512 + h * 64 + d]); mx = mn; }
        chk(err, 4, bf2f(M[(size_t)t * 1024 + h * 64 + d]), o / l, 1e-2f, 3e-2f);
        for (int dd = 0; dd < 64; ++dd) { const float v = bf2f(M[(size_t)t * 1024 + h * 64 + dd]); ssq += v * v; }
        chk(err, 4, ((const float*)(ws + WS_SSQA))[(size_t)t * 8 + h], ssq, 1e-3f, 3e-2f);
    } else if (SID < 8192 + 4096) { const bf16* Z = (const bf16*)(ws + WS_Z); const bf16* BG = (const bf16*)(ws + WS_BG); const int chs = (s >> 15) & 511; float ss = 0.f, mine = 0.f;
        for (int ch = 0; ch < 512; ++ch) { float zc = A.in[13][ch];
            for (int w = 0; w < 3; ++w) { const int ts = qi + w - 2; if (ts >= 0) zc += bf2f(Z[(size_t)(t + w - 2) * 512 + ch]) * A.in[12][w * 512 + ch]; }
            const float v = bf2f(BG[(size_t)t * 512 + ch]) * zc; ss += v * v; if (ch == chs) mine = v; }
        chk(err, 4, bf2f(M[(size_t)t * 1024 + 512 + chs]), mine * rsqrtf(ss / 512.f + RMS_EPS), 1e-2f, 2e-2f); }
}
__global__ void c5(MKArgs A) { unsigned char* ws = A.ws; unsigned* err = ERRP; const unsigned s = hsh(SID * 19 + 2);
    const int t = s & 32767, n = (s >> 15) & 1023, b = t / SEQ; const bf16* M = (const bf16*)(ws + WS_H) + (size_t)t * 1024; const bf16* W = (const bf16*)(ws + WS_WOUT) + (size_t)n * 1024;
    const float* sa = (const float*)(ws + WS_SSQA) + (size_t)t * 8; float a = 0.f; for (int i = 0; i < 8; ++i) a += sa[i]; const float ra = rsqrtf(a / 512.f + RMS_EPS);
    const float acc = ra * dotbf(M, W, 512) + dotbf(M + 512, W + 512, 512); const float* mod = (const float*)(ws + WS_MOD);
    chk(err, 5, bf2f(((const bf16*)(ws + WS_X1B))[(size_t)t * 1024 + n]), A.in[0][(size_t)t * 1024 + n] + mod[b * 6144 + 2048 + n] * acc, 2e-2f, 1e-2f);
}
__global__ void c6(MKArgs A) { unsigned char* ws = A.ws; unsigned* err = ERRP; const unsigned s = hsh(SID * 23 + 7);
    const int t = s & 32767, b = t / SEQ; const float* mod = (const float*)(ws + WS_MOD); const bf16* x1 = (const bf16*)(ws + WS_X1B) + (size_t)t * 1024; float r; { float q_ = 0.f; for (int k = 0; k < 1024; ++k) q_ += bf2f(x1[k]) * bf2f(x1[k]); r = rsqrtf(q_ / 1024.f + RMS_EPS); }
    { const int k = (s >> 15) & 1023; const float ref = bf2f(x1[k]) * r * A.in[17][k] * (1.f + mod[b * 6144 + 4096 + k]) + mod[b * 6144 + 3072 + k];
      chk(err, 6, bf2f(((const bf16*)(ws + WS_H))[(size_t)t * 1024 + k]), ref, 2e-3f, 1e-2f); }
    if (SID < 4096) { float gl[4] = {0, 0, 0, 0}, el[32]; for (int e = 0; e < 32; ++e) el[e] = 0.f;
        for (int k = 0; k < 1024; ++k) { const float hv = bf2f(x1[k]) * r * A.in[17][k] * (1.f + mod[b * 6144 + 4096 + k]) + mod[b * 6144 + 3072 + k];
            for (int e = 0; e < 4; ++e) gl[e] += hv * A.in[18][k * 4 + e]; for (int e = 0; e < 32; ++e) el[e] += hv * A.in[20][k * 32 + e]; }
        for (int e = 0; e < 4; ++e) gl[e] += A.in[19][e]; for (int e = 0; e < 32; ++e) el[e] += A.in[21][e];
        int gi = 0; for (int e = 1; e < 4; ++e) if (gl[e] > gl[gi]) gi = e; float g2 = -1e30f; for (int e = 0; e < 4; ++e) if (e != gi) g2 = fmaxf(g2, gl[e]);
        float se = 0.f; for (int e = 0; e < 4; ++e) se += expf(gl[e] - gl[gi]);
        int i0 = 0; for (int e = 1; e < 8; ++e) if (el[gi * 8 + e] > el[gi * 8 + i0]) i0 = e; int i1 = -1; for (int e = 0; e < 8; ++e) if (e != i0 && (i1 < 0 || el[gi * 8 + e] > el[gi * 8 + i1])) i1 = e;
        float v2 = -1e30f; for (int e = 0; e < 8; ++e) if (e != i0 && e != i1) v2 = fmaxf(v2, el[gi * 8 + e]);
        const float v0 = el[gi * 8 + i0], v1 = el[gi * 8 + i1];
        if (gl[gi] - g2 > 1e-3f && v0 - v1 > 1e-3f && v1 - v2 > 1e-3f) { const int* rt = (const int*)(ws + WS_ROUTE) + t * 4; const float e1 = expf(v1 - v0), pg = 1.f / se;
            if (rt[0] != gi * 8 + i0 || rt[1] != gi * 8 + i1) atomicAdd(&err[6], 1u);
            chk(err, 6, ((const float*)rt)[2], pg / (1.f + e1), 1e-3f, 1e-2f); chk(err, 6, ((const float*)rt)[3], pg * e1 / (1.f + e1), 1e-3f, 1e-2f); } }
    { const unsigned* cnt = (const unsigned*)(ws + WS_CTL) + CW_CNT; if (SID == 0) { unsigned tot = 0; for (int e = 0; e < 32; ++e) tot += cnt[CNT_IDX(e)]; if (tot != 65536u) atomicAdd(&err[6], 1u); }
      const int e = (s >> 3) & 31; const unsigned ce_ = cnt[CNT_IDX(e)]; const unsigned slot = (s >> 8) % (ce_ ? ce_ : 1u); if (ce_) { const int tk = ((const int*)(ws + WS_LTOK))[(size_t)e * LIST_CAP + slot];
        const int* rt = (const int*)(ws + WS_ROUTE) + (tk >> 1) * 4; if ((tk >> 1) < 0 || (tk >> 1) >= T || rt[tk & 1] != e) atomicAdd(&err[6], 1u);
        else chk(err, 6, ((const float*)(ws + WS_LW))[(size_t)e * LIST_CAP + slot], ((const float*)rt)[2 + (tk & 1)], 0.f, 0.f); } }
}
__global__ void c7(MKArgs A) { unsigned char* ws = A.ws; unsigned* err = ERRP; const unsigned s = hsh(SID * 29 + 13);
    const unsigned* cnt = (const unsigned*)(ws + WS_CTL) + CW_CNT; const int e = s & 31; if (!cnt[CNT_IDX(e)]) return; const unsigned slot = (s >> 5) % cnt[CNT_IDX(e)];
    int pb = 0; for (int i = 0; i < e; ++i) pb += (cnt[CNT_IDX(i)] + 255) >> 8;
    const int tk = ((const int*)(ws + WS_LTOK))[(size_t)e * LIST_CAP + slot]; const bf16* h2 = (const bf16*)(ws + WS_H) + (size_t)(tk >> 1) * 1024;
    const int j = (s >> 20) & 255, p = j >> 7, jj = j & 127; const bf16* W = (const bf16*)(ws + WS_WGU) + ((size_t)e * 512 + 256 * p + jj) * 1024;
    const float g = dotbf(h2, W, 1024), u = dotbf(h2, W + 128 * 1024, 1024);
    chk(err, 7, bf2f(((const bf16*)(ws + WS_ACT))[((size_t)pb * 256 + slot) * 256 + j]), g / (1.f + expf(-g)) * u, 2e-2f, 3e-2f);
}
__global__ void c8(MKArgs A) { unsigned char* ws = A.ws; unsigned* err = ERRP; const unsigned s = hsh(SID * 31 + 17);
    const unsigned* cnt = (const unsigned*)(ws + WS_CTL) + CW_CNT; const int e = s & 31; if (!cnt[CNT_IDX(e)]) return; const unsigned slot = (s >> 5) % cnt[CNT_IDX(e)];
    int pb = 0; for (int i = 0; i < e; ++i) pb += (cnt[CNT_IDX(i)] + 255) >> 8;
    const int tk = ((const int*)(ws + WS_LTOK))[(size_t)e * LIST_CAP + slot]; const float w = ((const float*)(ws + WS_LW))[(size_t)e * LIST_CAP + slot];
    const int n = (s >> 20) & 1023; const float ref = w * dotbf((const bf16*)(ws + WS_ACT) + ((size_t)pb * 256 + slot) * 256, (const bf16*)(ws + WS_WD) + ((size_t)e * 1024 + n) * 256, 256);
    chk(err, 8, bf2f(((const bf16*)(ws + WS_Y))[((size_t)(tk & 1) * T + (tk >> 1)) * 1024 + n]), ref, 5e-3f, 3e-2f);
}
__global__ void c9(MKArgs A, const float* gold, float* acc2) { float d = 0.f, r = 0.f;
    for (size_t i = SID; i < (size_t)T * 1024; i += (size_t)gridDim.x * blockDim.x) { const float a = A.xo[i], b = gold[i]; d += (a - b) * (a - b); r += b * b; if (!(fabsf(a) < 1e30f)) d += 1e30f; }
    d = wave_sum(d); r = wave_sum(r); if ((threadIdx.x & 63) == 0) { atomicAdd(&acc2[0], d); atomicAdd(&acc2[1], r); }
}
__global__ void report(MKArgs A, float* gold, const float* acc2, int use_mega) { unsigned char* ws = A.ws; const unsigned* err = ERRP;
    int code = 0; for (int i = 0; i < 9; ++i) if (err[i] != 0 && code == 0) code = i + 1;
    if (code == 0 && !(acc2[0] <= 3e-5f * acc2[1])) code = 10;
    const float f = 1.f + 0.03f * code;
    for (size_t i = SID; i < (size_t)T * 1024; i += (size_t)gridDim.x * blockDim.x) gold[i] = (use_mega && code == 0 ? A.xo[i] : gold[i]) * f;
}
}
#endif
extern "C" void kernel_launch(void* const* d_in, const int* in_sizes, int n_in, void* d_out, int out_size, void* d_ws, size_t ws_size, hipStream_t stream) {
    static int grid = 0;
    if (grid == 0) {
        int dev = 0, cus = 0, per_cu = 0;
        if (n_in != 26 || out_size != T * DM || ws_size < 496 * MiB) { fprintf(stderr, "kernel_launch: unexpected problem (n_in %d out %d ws %zu)\n", n_in, out_size, ws_size); grid = -1; return; }
        if (hipGetDevice(&dev) != hipSuccess || hipDeviceGetAttribute(&cus, hipDeviceAttributeMultiprocessorCount, dev) != hipSuccess) { grid = -1; return; }
        if (hipFuncSetAttribute((const void*)mk_fwd, hipFuncAttributeMaxDynamicSharedMemorySize, LDS_BYTES) != hipSuccess) { fprintf(stderr, "kernel_launch: hipFuncSetAttribute failed\n"); grid = -1; return; }
        if (hipOccupancyMaxActiveBlocksPerMultiprocessor(&per_cu, (const void*)mk_fwd, NTHR, LDS_BYTES) != hipSuccess || per_cu < 1) { fprintf(stderr, "kernel_launch: occupancy query says %d\n", per_cu); }
        (void)hipGetLastError();
        grid = cus;
    }
    if (grid < 0) return;
    MKArgs a{};
    for (int i = 0; i < 26; ++i) a.in[i] = (const float*)d_in[i];
    a.ws = (unsigned char*)d_ws;
#if MK_DEBUG
    nv::run(d_in, (float*)d_out, (char*)d_ws, stream);
    (void)hipMemsetAsync(d_ws, 0, ZERO_BYTES, stream);
    a.xo = (float*)((char*)d_ws + WS_X1DBG);
    for (int p = 0; p < N_PHASES; ++p) {
        a.ph_lo = p; a.ph_hi = p + 1;
        hipLaunchKernelGGL(mk_fwd, dim3(grid), dim3(NTHR), LDS_BYTES, stream, a);
        switch (p) {
            case 0: hipLaunchKernelGGL(ck::c0, dim3(64), dim3(256), 0, stream, a); break;
            case 1: hipLaunchKernelGGL(ck::c1, dim3(64), dim3(256), 0, stream, a); break;
            case 2: hipLaunchKernelGGL(ck::c2, dim3(64), dim3(256), 0, stream, a); break;
            case 3: hipLaunchKernelGGL(ck::c3, dim3(64), dim3(256), 0, stream, a); break;
            case 4: hipLaunchKernelGGL(ck::c4, dim3(64), dim3(256), 0, stream, a); break;
            case 5: hipLaunchKernelGGL(ck::c5, dim3(64), dim3(256), 0, stream, a); break;
            case 6: hipLaunchKernelGGL(ck::c6, dim3(64), dim3(256), 0, stream, a); break;
            case 7: hipLaunchKernelGGL(ck::c7, dim3(64), dim3(256), 0, stream, a); break;
            case 8: hipLaunchKernelGGL(ck::c8, dim3(64), dim3(256), 0, stream, a); break;
            default: break;
        }
    }
    float* acc2 = (float*)((char*)d_ws + WS_CTL) + 1024;
    hipLaunchKernelGGL(ck::c9, dim3(1024), dim3(256), 0, stream, a, (const float*)d_out, acc2);
    hipLaunchKernelGGL(ck::report, dim3(1024), dim3(256), 0, stream, a, (float*)d_out, (const float*)acc2, MK_DEBUG_USE_MEGA);
#else
    (void)hipMemsetAsync(d_ws, 0, ZERO_BYTES, stream);
    a.xo = (float*)d_out; a.ph_lo = 0; a.ph_hi = N_PHASES;
    hipLaunchKernelGGL(mk_fwd, dim3(grid), dim3(NTHR), LDS_BYTES, stream, a);
#endif
}
```
